# Optimizing an MI355X kernel written in HIP

```python
import math
import jax, jax.numpy as jnp
from jax import lax
import numpy as np

D_MODEL = 1024
BATCH = 8
SEQ = 4096
DEPTH = 4
DEC_BATCH = 4
DEC_SEQ = 4096
PAST_LEN = 128

N_HEADS = 8
HEAD_DIM = 64
V_DIM = 2 * HEAD_DIM
W_A = N_HEADS * V_DIM
QK_WIDTH = N_HEADS * 2 * HEAD_DIM
SCALE = HEAD_DIM ** -0.5
QBLK = 128
NUM_BUCKETS = 32
MAX_DISTANCE = 128
W_B = D_MODEL
CONV_W = 3
PROJ_WIDTHS = [QK_WIDTH, QK_WIDTH, W_A, W_A, W_B, W_B, W_B, W_B, D_MODEL, D_MODEL]
PROJ_SPLITS = [int(s) for s in np.cumsum(PROJ_WIDTHS)[:-1]]
N_PROJ = int(sum(PROJ_WIDTHS))
EPS = 1e-6

kernel_name = "hybrid_diffattn_shortconv_encoder"


def rmsnorm(x, g):
    xf = x.astype(jnp.float32)
    r = xf * lax.rsqrt(jnp.mean(xf * xf, axis=-1, keepdims=True) + EPS)
    return (r * g.astype(jnp.float32)).astype(x.dtype)


def lambda_init_fn(layer_idx):
    return 0.8 - 0.6 * math.exp(-0.3 * layer_idx)


def rel_bucket(rel):
    nb = NUM_BUCKETS // 2
    ret = (rel > 0).astype(jnp.int32) * nb
    n = jnp.abs(rel)
    max_exact = nb // 2
    is_small = n < max_exact
    nf = jnp.maximum(n, 1).astype(jnp.float32)
    large = max_exact + (jnp.log(nf / max_exact) / math.log(MAX_DISTANCE / max_exact) * (nb - max_exact)).astype(jnp.int32)
    large = jnp.minimum(large, nb - 1)
    return ret + jnp.where(is_small, n, large)


def diff_attention(q, k, v, rel_bias, q_norm_g, k_norm_g, lam):
    B, S, _ = q.shape
    q = rmsnorm(q.reshape(B, S, N_HEADS, 2, HEAD_DIM), q_norm_g) * SCALE
    k = rmsnorm(k.reshape(B, S, N_HEADS, 2, HEAD_DIM), k_norm_g)
    q1 = q[..., 0, :].transpose(0, 2, 1, 3)
    q2 = q[..., 1, :].transpose(0, 2, 1, 3)
    k1 = k[..., 0, :].transpose(0, 2, 1, 3)
    k2 = k[..., 1, :].transpose(0, 2, 1, 3)
    vh = v.reshape(B, S, N_HEADS, V_DIM).transpose(0, 2, 1, 3)
    nq = S // QBLK
    q1b = q1.reshape(B, N_HEADS, nq, QBLK, HEAD_DIM).transpose(2, 0, 1, 3, 4)
    q2b = q2.reshape(B, N_HEADS, nq, QBLK, HEAD_DIM).transpose(2, 0, 1, 3, 4)
    starts = jnp.arange(nq, dtype=jnp.int32) * QBLK
    kpos = jnp.arange(S, dtype=jnp.int32)
    qoff = jnp.arange(QBLK, dtype=jnp.int32)

    def block(args):
        q1i, q2i, st = args
        rel = kpos[None, :] - (st + qoff)[:, None]
        bias = rel_bias[rel_bucket(rel)].transpose(2, 0, 1).astype(jnp.float32)
        s1 = jnp.einsum("bhqd,bhkd->bhqk", q1i, k1).astype(jnp.float32) + bias
        s2 = jnp.einsum("bhqd,bhkd->bhqk", q2i, k2).astype(jnp.float32) + bias
        a = jax.nn.softmax(s1, axis=-1) - lam * jax.nn.softmax(s2, axis=-1)
        return jnp.einsum("bhqk,bhkv->bhqv", a.astype(vh.dtype), vh)

    o = lax.map(block, (q1b, q2b, starts))
    return o.transpose(1, 0, 3, 2, 4).reshape(B, S, N_HEADS, V_DIM)


def centred_conv3(u, w):
    up = jnp.pad(u, ((0, 0), (1, 1), (0, 0)))
    return up[:, :-2] * w[0] + up[:, 1:-1] * w[1] + up[:, 2:] * w[2]


def layer(x, layer_idx, rel_bias, norm_g, w_in, q_norm_g, k_norm_g, lambda_q1, lambda_k1,
          lambda_q2, lambda_k2, subln_g, w_attn_out, conv_w, w_conv_out, w_o):
    B, S, _ = x.shape
    h = rmsnorm(x, norm_g)
    proj = h @ w_in
    q, k, v, g_a, x_c, c_g, b_g, g_b, m_a, m_b = jnp.split(proj, PROJ_SPLITS, axis=-1)
    lam_init = lambda_init_fn(layer_idx)
    lam = (jnp.exp(jnp.sum(lambda_q1.astype(jnp.float32) * lambda_k1.astype(jnp.float32)))
           - jnp.exp(jnp.sum(lambda_q2.astype(jnp.float32) * lambda_k2.astype(jnp.float32)))
           + lam_init)
    o = diff_attention(q, k, v, rel_bias, q_norm_g, k_norm_g, lam)
    o = rmsnorm(o, subln_g) * (1.0 - lam_init)
    y_a = (o.reshape(B, S, W_A) * jax.nn.silu(g_a)) @ w_attn_out
    cv = centred_conv3(c_g * x_c, conv_w)
    y_b = (b_g * cv * jax.nn.silu(g_b)) @ w_conv_out
    merged = jax.nn.sigmoid(m_a) * y_a + jax.nn.sigmoid(m_b) * y_b
    return x + merged @ w_o


def trunk(x, rel_bias, norm_g, w_in, q_norm_g, k_norm_g, lambda_q1, lambda_k1, lambda_q2,
          lambda_k2, subln_g, w_attn_out, conv_w, w_conv_out, w_o):
    for l in range(DEPTH):
        x = layer(x, l, rel_bias, norm_g[l], w_in[l], q_norm_g[l], k_norm_g[l],
                  lambda_q1[l], lambda_k1[l], lambda_q2[l], lambda_k2[l], subln_g[l],
                  w_attn_out[l], conv_w[l], w_conv_out[l], w_o[l])
    return x


def setup_inputs(seed: int = 0) -> dict:
    key = jax.random.key(seed)
    ks = jax.random.split(key, 17)
    f32 = jnp.float32
    nrm = lambda k, s, sc: jax.random.normal(k, s, f32) * sc
    return {
        "x_prompt": nrm(ks[0], (BATCH, SEQ, D_MODEL), 1.0),
        "x_sample": nrm(ks[1], (DEC_BATCH, DEC_SEQ, D_MODEL), 1.0),
        "rel_bias": nrm(ks[2], (NUM_BUCKETS, N_HEADS), 0.3),
        "norm_g": 1.0 + nrm(ks[3], (DEPTH, D_MODEL), 0.02),
        "w_in": nrm(ks[4], (DEPTH, D_MODEL, N_PROJ), D_MODEL ** -0.5),
        "q_norm_g": 1.0 + nrm(ks[5], (DEPTH, HEAD_DIM), 0.02),
        "k_norm_g": 1.0 + nrm(ks[6], (DEPTH, HEAD_DIM), 0.02),
        "lambda_q1": nrm(ks[7], (DEPTH, HEAD_DIM), 0.1),
        "lambda_k1": nrm(ks[8], (DEPTH, HEAD_DIM), 0.1),
        "lambda_q2": nrm(ks[9], (DEPTH, HEAD_DIM), 0.1),
        "lambda_k2": nrm(ks[10], (DEPTH, HEAD_DIM), 0.1),
        "subln_g": 1.0 + nrm(ks[11], (DEPTH, V_DIM), 0.02),
        "w_attn_out": nrm(ks[12], (DEPTH, W_A, D_MODEL), W_A ** -0.5),
        "conv_w": nrm(ks[13], (DEPTH, CONV_W, W_B), CONV_W ** -0.5),
        "w_conv_out": nrm(ks[14], (DEPTH, W_B, D_MODEL), W_B ** -0.5),
        "w_o": nrm(ks[15], (DEPTH, D_MODEL, D_MODEL), D_MODEL ** -0.5),
    }


def reference(x_prompt, x_sample, rel_bias, norm_g, w_in, q_norm_g, k_norm_g, lambda_q1,
              lambda_k1, lambda_q2, lambda_k2, subln_g, w_attn_out, conv_w, w_conv_out, w_o):
    y_prompt = trunk(x_prompt, rel_bias, norm_g, w_in, q_norm_g, k_norm_g, lambda_q1, lambda_k1,
                     lambda_q2, lambda_k2, subln_g, w_attn_out, conv_w, w_conv_out, w_o)
    y_sample = trunk(x_sample, rel_bias, norm_g, w_in, q_norm_g, k_norm_g, lambda_q1, lambda_k1,
                     lambda_q2, lambda_k2, subln_g, w_attn_out, conv_w, w_conv_out, w_o)
    return (y_prompt, y_sample)
```

```cpp
#include <hip/hip_runtime.h>
#include <hip/hip_cooperative_groups.h>
#include <cstdio>
#include <cstdint>
namespace cgx = cooperative_groups;
namespace pg8 {
#define PG8_LAS __attribute__((address_space(3)))
typedef unsigned short bf16_t;
typedef short bf16x8 __attribute__((ext_vector_type(8)));
typedef float f32x4 __attribute__((ext_vector_type(4)));
typedef unsigned u32x4 __attribute__((ext_vector_type(4)));
constexpr int BM = 256, BK = 64, HALF = 128, HTB = HALF * BK * 2  , STAGE_BYTES = 8 * HTB, NXCD = 8, WGM = 8;

__host__ __device__ __forceinline__ int lds_byte(int r, int c) { const int st = (r >> 4) * 2 + (c >> 5), rr = r & 15, cc = c & 31, ob = rr * 64 + cc * 2; return st * 1024 + (ob ^ (((ob >> 9) & 1) << 5)); }
__host__ __device__ __forceinline__ void stage_rc(int b, int& R, int& C) { const int st = b / 1024, sb = b % 1024, swz = sb ^ (((sb >> 9) & 1) << 5); R = (st >> 1) * 16 + swz / 64; C = (st & 1) * 32 + (swz % 64) / 2; }
__host__ __device__ __forceinline__ int perm32(int rho) { const int n = rho >> 4, i = rho & 15; return 8 * (i >> 2) + 4 * n + (i & 3); }

struct Unit { int pm, pn, w; };
struct Gemm { const bf16_t* A; const bf16_t* Bt; int M, N, K; const bf16_t* A2; const bf16_t* Bt2; };

struct StaticOrder {
    int nM, nN, nwg, G, c;
    __host__ __device__ void init(int M, int N, int G_, int c_) { nM = M / BM; nN = N / BM; nwg = nM * nN; G = G_; c = c_; }
    __host__ __device__ bool next(int i, Unit& u) const { return map((long)i * G + c, u); }
    __host__ __device__ bool map(long L, Unit& u) const {
        if (L >= nwg) return false; u.w = 0;
        int wgid = (int)L; { const int q = nwg / NXCD, r = nwg % NXCD, xcd = wgid % NXCD, off = wgid / NXCD; wgid = (xcd < r ? xcd * (q + 1) : r * (q + 1) + (xcd - r) * q) + off; }
        const int nig = WGM * nN, gid = wgid / nig, fm = gid * WGM, gsz = (nM - fm) < WGM ? (nM - fm) : WGM;
        u.pm = fm + ((wgid % nig) % gsz); u.pn = (wgid % nig) / gsz; return true;
    }
    __device__ __forceinline__ void a_ready(const Unit&) const {}
    __device__ __forceinline__ void done(const Unit&) const {}
};
struct DualOrder {
    StaticOrder s0, s1; int G, c;
    __host__ __device__ bool next(int i, Unit& u) const {
        long L = (long)i * G + c; const bool second = L >= s0.nwg; if (second) L -= s0.nwg;
        StaticOrder t; t.nM = second ? s1.nM : s0.nM; t.nN = second ? s1.nN : s0.nN; t.nwg = second ? s1.nwg : s0.nwg; t.G = G; t.c = c;
        const bool ok = t.map(L, u); u.w = second ? 1 : 0; return ok; }
    __device__ __forceinline__ void a_ready(const Unit&) const {}
    __device__ __forceinline__ void done(const Unit&) const {}
};

__device__ __forceinline__ unsigned cvt_pk_bf16(float lo, float hi) { unsigned r; asm volatile("v_cvt_pk_bf16_f32 %0, %1, %2" : "=v"(r) : "v"(lo), "v"(hi)); return r; }
typedef float f32x2 __attribute__((ext_vector_type(2)));
template <class Epi, class Sched, bool ALIGN_EPI = false, bool SP2 = false>
__device__ __forceinline__ void gemm_phase(PG8_LAS unsigned char* lds, const Gemm g, const Sched& S, const Epi& E) {
    int tid_l = threadIdx.x; asm volatile("" : "+v"(tid_l));
    const int tid = tid_l, wid = __builtin_amdgcn_readfirstlane(tid >> 6), lane = tid & 63, wr = wid >> 2, wc = wid & 3, fr = lane & 15, fq = lane >> 4;
    const int K = g.K, nt = K / BK;
    unsigned voffA[2], voffB[2];
#pragma unroll
    for (int i = 0; i < 2; ++i) { int R, C; stage_rc(tid * 16 + i * 8192, R, C); const int Rb = Epi::PERM ? ((R & ~31) + perm32(R & 31)) : R;
        voffA[i] = (unsigned)(R * K + C) * 2u; voffB[i] = (unsigned)(Rb * K + C) * 2u; }
    const size_t kstep = (size_t)(BK * 2);
    const size_t hstep = (size_t)HALF * K * 2;
    const size_t tstep = 2 * hstep;
    const unsigned ldsw = (unsigned)wid * 1024u;
    const int aoff = lds_byte(wr * 64 + fr, fq * 8), boff = lds_byte(wc * 32 + fr, fq * 8);
#define PG8_SA(b, h) (((b) * 2 + (h)) * HTB)
#define PG8_SB(b, h) ((4 + (b) * 2 + (h)) * HTB)
#define PG8_STAGE(bufoff, gbase, voff) do { _Pragma("unroll") for (int _i = 0; _i < 2; ++_i) \
        __builtin_amdgcn_global_load_lds((const unsigned*)((const char*)(gbase) + (voff)[_i]), (PG8_LAS unsigned*)(lds + (bufoff) + ldsw + _i * 8192), 16, 0, 0); } while (0)
#define PG8_LDA(dst, b, h) do { _Pragma("unroll") for (int m = 0; m < 4; ++m) _Pragma("unroll") for (int k = 0; k < 2; ++k) dst[m][k] = *(const PG8_LAS bf16x8*)(lds + PG8_SA(b, h) + aoff + m * 2048 + k * 1024); } while (0)
#define PG8_LDB(dst, b, h) do { _Pragma("unroll") for (int n = 0; n < 2; ++n) _Pragma("unroll") for (int k = 0; k < 2; ++k) dst[n][k] = *(const PG8_LAS bf16x8*)(lds + PG8_SB(b, h) + boff + n * 2048 + k * 1024); } while (0)
#define PG8_MMA(ai, bj, At, Bt) do { __builtin_amdgcn_s_setprio(1); _Pragma("unroll") for (int m = 0; m < 4; ++m) _Pragma("unroll") for (int n = 0; n < 2; ++n) _Pragma("unroll") for (int k = 0; k < 2; ++k) \
        acc[ai][bj][m][n] = __builtin_amdgcn_mfma_f32_16x16x32_bf16(Bt[n][k], At[m][k], acc[ai][bj][m][n], 0, 0, 0); __builtin_amdgcn_s_setprio(0); } while (0)
#define PG8_WAIT_V(n) asm volatile("s_waitcnt vmcnt(" #n ")" ::: "memory")
#define PG8_WAIT_L(n) asm volatile("s_waitcnt lgkmcnt(" #n ")" ::: "memory")
#define PG8_BAR __builtin_amdgcn_s_barrier()
#define PG8_SCHED __builtin_amdgcn_sched_barrier(0)
    Unit cur, nxt; int ui = 0;
    if (!S.next(0, cur)) return;
    f32x4 acc[2][2][4][2];
#pragma unroll
    for (int a = 0; a < 2; ++a)
#pragma unroll
        for (int b = 0; b < 2; ++b)
#pragma unroll
            for (int m = 0; m < 4; ++m)
#pragma unroll
                for (int n = 0; n < 2; ++n) acc[a][b][m][n] = (f32x4){0.f, 0.f, 0.f, 0.f};
    bf16x8 At[4][2], B0[2][2], B1[2][2];
    const char* const gA0 = (const char*)g.A; const char* const gA1 = (const char*)g.A2; const char* const gB0 = (const char*)g.Bt; const char* const gB1 = (const char*)g.Bt2;
    const char* cA = (cur.w != 0 ? gA1 : gA0) + (size_t)cur.pm * tstep; const char* cB = (cur.w != 0 ? gB1 : gB0) + (size_t)cur.pn * tstep;
    S.a_ready(cur);
    if constexpr (SP2) {
        PG8_STAGE(PG8_SB(0, 0), cB, voffB); PG8_STAGE(PG8_SB(0, 1), cB + hstep, voffB); PG8_STAGE(PG8_SA(0, 0), cA, voffA); PG8_STAGE(PG8_SA(0, 1), cA + hstep, voffA);
        if (wr == 1) PG8_BAR;
        PG8_WAIT_V(2); PG8_BAR;
        PG8_STAGE(PG8_SB(1, 0), cB + kstep, voffB); PG8_STAGE(PG8_SA(1, 0), cA + kstep, voffA); PG8_STAGE(PG8_SB(1, 1), cB + hstep + kstep, voffB);
        PG8_WAIT_V(6); PG8_BAR;
    } else {
        PG8_STAGE(PG8_SB(0, 0), cB, voffB); PG8_STAGE(PG8_SA(0, 0), cA, voffA); PG8_STAGE(PG8_SB(0, 1), cB + hstep, voffB); PG8_STAGE(PG8_SA(0, 1), cA + hstep, voffA);
        if (wr == 1) PG8_BAR;
        PG8_WAIT_V(4); PG8_BAR;
        PG8_STAGE(PG8_SB(1, 0), cB + kstep, voffB); PG8_STAGE(PG8_SA(1, 0), cA + kstep, voffA); PG8_STAGE(PG8_SB(1, 1), cB + hstep + kstep, voffB);
        PG8_WAIT_V(6); PG8_BAR;
    }
    for (;;) {
        const bool has_next = S.next(ui + 1, nxt);
        const char* nA = has_next ? (nxt.w != 0 ? gA1 : gA0) + (size_t)nxt.pm * tstep : cA; const char* nB = has_next ? (nxt.w != 0 ? gB1 : gB0) + (size_t)nxt.pn * tstep : cB;
        for (int t = 0; t < nt; t += 2) {
            const bool last = (t == nt - 2);
            const char* a1 = cA + (size_t)(t + 1) * kstep;
            const char* a2 = last ? nA : cA + (size_t)(t + 2) * kstep; const char* b2 = last ? nB : cB + (size_t)(t + 2) * kstep;
            const char* a3 = a2 + kstep; const char* b3 = b2 + kstep;
            if (last && has_next) S.a_ready(nxt);
            if constexpr (SP2) {
            PG8_LDB(B0, 0, 0); PG8_LDB(B1, 0, 1); PG8_SCHED; PG8_LDA(At, 0, 0); PG8_STAGE(PG8_SA(1, 1), a1 + hstep, voffA);
            PG8_WAIT_V(8); PG8_WAIT_L(0); PG8_BAR; PG8_MMA(0, 0, At, B0); PG8_MMA(0, 1, At, B1); PG8_BAR; PG8_SCHED;
            PG8_LDA(At, 0, 1); PG8_STAGE(PG8_SB(0, 0), b2, voffB); PG8_STAGE(PG8_SB(0, 1), b2 + hstep, voffB); PG8_STAGE(PG8_SA(0, 0), a2, voffA);
            PG8_WAIT_V(8); PG8_WAIT_L(0); PG8_BAR; PG8_MMA(1, 0, At, B0); PG8_MMA(1, 1, At, B1); PG8_BAR; PG8_SCHED;
            PG8_LDB(B0, 1, 0); PG8_LDB(B1, 1, 1); PG8_SCHED; PG8_LDA(At, 1, 0); PG8_STAGE(PG8_SA(0, 1), a2 + hstep, voffA);
            PG8_WAIT_V(8); PG8_WAIT_L(0); PG8_BAR; PG8_MMA(0, 0, At, B0); PG8_MMA(0, 1, At, B1); PG8_BAR; PG8_SCHED;
            PG8_LDA(At, 1, 1); PG8_STAGE(PG8_SB(1, 0), b3, voffB); PG8_STAGE(PG8_SB(1, 1), b3 + hstep, voffB); PG8_STAGE(PG8_SA(1, 0), a3, voffA);
            PG8_WAIT_V(8); PG8_WAIT_L(0); PG8_BAR; PG8_MMA(1, 0, At, B0); PG8_MMA(1, 1, At, B1); PG8_BAR; PG8_SCHED;
            } else {
            PG8_LDB(B0, 0, 0); PG8_SCHED; PG8_LDA(At, 0, 0); PG8_STAGE(PG8_SA(1, 1), a1 + hstep, voffA);
            PG8_WAIT_L(8); PG8_BAR; PG8_WAIT_L(0); PG8_MMA(0, 0, At, B0); PG8_BAR; PG8_SCHED;
            PG8_LDB(B1, 0, 1); PG8_STAGE(PG8_SB(0, 0), b2, voffB);
            PG8_BAR; PG8_WAIT_L(0); PG8_MMA(0, 1, At, B1); PG8_BAR;
            PG8_LDA(At, 0, 1); PG8_STAGE(PG8_SA(0, 0), a2, voffA);
            PG8_BAR; PG8_WAIT_L(0); PG8_MMA(1, 0, At, B0); PG8_BAR; PG8_SCHED;
            PG8_STAGE(PG8_SB(0, 1), b2 + hstep, voffB);
            PG8_WAIT_V(6); PG8_BAR; PG8_MMA(1, 1, At, B1); PG8_BAR;
            PG8_LDB(B0, 1, 0); PG8_SCHED; PG8_LDA(At, 1, 0); PG8_STAGE(PG8_SA(0, 1), a2 + hstep, voffA);
            PG8_WAIT_L(8); PG8_BAR; PG8_WAIT_L(0); PG8_MMA(0, 0, At, B0); PG8_BAR; PG8_SCHED;
            PG8_LDB(B1, 1, 1); PG8_STAGE(PG8_SB(1, 0), b3, voffB);
            PG8_BAR; PG8_WAIT_L(0); PG8_MMA(0, 1, At, B1); PG8_BAR;
            PG8_LDA(At, 1, 1); PG8_STAGE(PG8_SA(1, 0), a3, voffA);
            PG8_BAR; PG8_WAIT_L(0); PG8_MMA(1, 0, At, B0); PG8_BAR; PG8_SCHED;
            PG8_STAGE(PG8_SB(1, 1), b3 + hstep, voffB);
            PG8_WAIT_V(6); PG8_BAR; PG8_MMA(1, 1, At, B1); PG8_BAR;
            }
        }
        if constexpr (ALIGN_EPI) { if (wr == 0) PG8_BAR; }
        if constexpr (!Epi::AFTER_DRAIN) { E(acc, cur, wr, wc, fr, fq); S.done(cur); }
        if (!has_next) break;
#pragma unroll
        for (int a = 0; a < 2; ++a)
#pragma unroll
            for (int b = 0; b < 2; ++b)
#pragma unroll
                for (int m = 0; m < 4; ++m)
#pragma unroll
                    for (int n = 0; n < 2; ++n) acc[a][b][m][n] = (f32x4){0.f, 0.f, 0.f, 0.f};
        cur = nxt; cA = nA; cB = nB; ++ui;
        if constexpr (ALIGN_EPI) { if (wr == 1) PG8_BAR; }
    }
    PG8_WAIT_V(0);
    if constexpr (!ALIGN_EPI) { if (wr == 0) PG8_BAR; }
    PG8_BAR;
    if constexpr (Epi::AFTER_DRAIN) { E.fused(acc, cur, wr, wc, fr, fq, lds, wid, lane); S.done(cur); }
#undef PG8_SA
#undef PG8_SB
#undef PG8_STAGE
#undef PG8_LDA
#undef PG8_LDB
#undef PG8_MMA
#undef PG8_WAIT_V
#undef PG8_WAIT_L
#undef PG8_BAR
#undef PG8_SCHED
}
}
#define LAS __attribute__((address_space(3)))
typedef unsigned short bf16_t;
typedef short bf16x8 __attribute__((ext_vector_type(8)));
typedef float f32x4 __attribute__((ext_vector_type(4)));
typedef float f32x16 __attribute__((ext_vector_type(16)));
typedef unsigned u32x4 __attribute__((ext_vector_type(4)));
typedef unsigned u32x2 __attribute__((ext_vector_type(2)));
constexpr int DM = 1024, SEQL = 4096, NSEQ = 12, MTOT = NSEQ * SEQL, CH_SEQ = 4, MC = CH_SEQ * SEQL, NCHUNK = NSEQ / CH_SEQ, DEPTH = 4;
constexpr int NPROJ = 10240, NIN = 9216;
constexpr float EPS = 1e-6f, LOG2E = 1.4426950408889634f;
constexpr size_t MiB = 1u << 20;
constexpr size_t WS_MISC = 0, WS_PART = 1 * MiB, WS_WIN = 4 * MiB, WS_WV = 76 * MiB, WS_WA = 84 * MiB, WS_WB = 92 * MiB, WS_WO = 100 * MiB, WS_XB = 108 * MiB,
                 WS_Q = 204 * MiB, WS_K = 236 * MiB, WS_VT = 268 * MiB, WS_GA = 300 * MiB, WS_U = 332 * MiB, WS_W = 364 * MiB, WS_MA = 396 * MiB, WS_MB = 428 * MiB, WS_BC = 460 * MiB, WS_END = 492 * MiB;
constexpr int TABN = 640, TABZ = 320;
constexpr int LDS_BYTES = 147456;

__device__ __forceinline__ float bf2f(unsigned short b) { return __uint_as_float(((unsigned)b) << 16); }
__device__ __forceinline__ float bflo(unsigned w) { return __uint_as_float(w << 16); }
__device__ __forceinline__ float bfhi(unsigned w) { return __uint_as_float(w & 0xffff0000u); }
__device__ __forceinline__ unsigned pkbf(float lo, float hi) { return pg8::cvt_pk_bf16(lo, hi); }
__device__ __forceinline__ float fast_rcp(float x) { return __builtin_amdgcn_rcpf(x); }
__device__ __forceinline__ float sigmoidf_(float x) { return fast_rcp(1.f + __builtin_amdgcn_exp2f(-x * LOG2E)); }
__device__ __forceinline__ float siluf_(float x) { return x * sigmoidf_(x); }
__device__ __forceinline__ f32x4 ld4(const float* p) { return *(const f32x4*)p; }

__device__ __forceinline__ float row_rstd(const float* part, int row) {
    const f32x4 a = ld4(part + (size_t)row * 16), b = ld4(part + (size_t)row * 16 + 4), c = ld4(part + (size_t)row * 16 + 8), d = ld4(part + (size_t)row * 16 + 12);
    const f32x4 s = (a + b) + (c + d);
    return __builtin_amdgcn_rsqf(((s[0] + s[1]) + (s[2] + s[3])) * (1.0f / DM) + EPS);
}
struct EpiInProj {
    static constexpr bool PERM = true, AFTER_DRAIN = false;
    const float* part; unsigned char* wsb; const float *gq, *gk, *cw;
    __device__ __forceinline__ void operator()(const f32x4 (&acc)[2][2][4][2], const pg8::Unit& u, int wr, int wc, int fr, int fq) const {
        const int pn = u.pn, rowb = u.pm * 256 + wr * 64 + fr;
        if (pn < 8) {
            const bool isq = pn < 4; const float* g = isq ? gq : gk; const float cs = isq ? 0.125f * LOG2E : 1.f; bf16_t* O = (bf16_t*)(wsb + (isq ? WS_Q : WS_K));
            const int cb = (pn & 3) * 256 + 64 * wc + 8 * fq;
            f32x4 gv[2][2];
#pragma unroll
            for (int bj = 0; bj < 2; ++bj)
#pragma unroll
                for (int n = 0; n < 2; ++n) gv[bj][n] = ld4(g + 32 * bj + 8 * fq + 4 * n) * cs;
#pragma unroll
            for (int ai = 0; ai < 2; ++ai)
#pragma unroll
                for (int m = 0; m < 4; ++m) {
                    const float rsv = row_rstd(part, rowb + ai * 128 + m * 16); float ss = 0.f;
#pragma unroll
                    for (int bj = 0; bj < 2; ++bj)
#pragma unroll
                        for (int n = 0; n < 2; ++n) { const f32x4 q = acc[ai][bj][m][n] * acc[ai][bj][m][n]; ss += (q[0] + q[1]) + (q[2] + q[3]); }
                    ss += __shfl_xor(ss, 16); ss += __shfl_xor(ss, 32);
                    const float r = __builtin_amdgcn_rsqf(ss * rsv * rsv * (1.0f / 64.0f) + EPS) * rsv;
                    bf16_t* rowp = O + (size_t)(rowb + ai * 128 + m * 16) * DM + cb;
#pragma unroll
                    for (int bj = 0; bj < 2; ++bj) { const f32x4 a = acc[ai][bj][m][0] * r * gv[bj][0], b = acc[ai][bj][m][1] * r * gv[bj][1];
                        u32x4 w; w.x = pkbf(a[0], a[1]); w.y = pkbf(a[2], a[3]); w.z = pkbf(b[0], b[1]); w.w = pkbf(b[2], b[3]); *(u32x4*)(rowp + 32 * bj) = w; }
                }
        } else if (pn >= 12 && pn < 28) {
            const int ch0 = 64 * (pn - 12) + 16 * wc + 4 * fq;
            const f32x4 c0 = ld4(cw + ch0), c1 = ld4(cw + DM + ch0), c2 = ld4(cw + 2 * DM + ch0);
            bf16_t* Up = (bf16_t*)(wsb + WS_U); bf16_t* Wp = (bf16_t*)(wsb + WS_W); bf16_t* Bp = (bf16_t*)(wsb + WS_BC);
#pragma unroll
            for (int ai = 0; ai < 2; ++ai) {
                f32x4 uu[4], ww[4], up[4], un[4];
#pragma unroll
                for (int m = 0; m < 4; ++m) {
                    const float r = row_rstd(part, rowb + ai * 128 + m * 16); const f32x4 xc = acc[ai][0][m][0] * r, cg = acc[ai][0][m][1] * r, bg = acc[ai][1][m][0] * r, gb = acc[ai][1][m][1] * r;
                    uu[m] = cg * xc;
#pragma unroll
                    for (int e = 0; e < 4; ++e) { ww[m][e] = bg[e] * siluf_(gb[e]);
                        up[m][e] = __int_as_float(__builtin_amdgcn_mov_dpp(__float_as_int(uu[m][e]), 0x121, 0xf, 0xf, false));
                        un[m][e] = __int_as_float(__builtin_amdgcn_mov_dpp(__float_as_int(uu[m][e]), 0x12f, 0xf, 0xf, false)); }
                }
#pragma unroll
                for (int m = 0; m < 4; ++m) {
                    const f32x4 z = {0.f, 0.f, 0.f, 0.f};
                    const f32x4 pv = (fr == 0) ? (m > 0 ? up[m > 0 ? m - 1 : 0] : z) : up[m], nv = (fr == 15) ? (m < 3 ? un[m < 3 ? m + 1 : 3] : z) : un[m];
                    const f32x4 bc = ww[m] * (c0 * pv + c1 * uu[m] + c2 * nv);
                    const size_t off = (size_t)(rowb + ai * 128 + m * 16) * DM + ch0;
                    const bool bnd = (m == 0 && fr == 0) || (m == 3 && fr == 15);
                    if (!bnd) { u32x2 o; o.x = pkbf(bc[0], bc[1]); o.y = pkbf(bc[2], bc[3]); *(u32x2*)(Bp + off) = o; }
                    if ((m == 0 && fr <= 1) || (m == 3 && fr >= 14)) {
                        u32x2 a; a.x = pkbf(uu[m][0], uu[m][1]); a.y = pkbf(uu[m][2], uu[m][3]); *(u32x2*)(Up + off) = a;
                        u32x2 b; b.x = pkbf(ww[m][0], ww[m][1]); b.y = pkbf(ww[m][2], ww[m][3]); *(u32x2*)(Wp + off) = b; }
                }
            }
        } else {
            const bool isga = pn < 12; bf16_t* O = (bf16_t*)(wsb + (isga ? WS_GA : (pn < 32 ? WS_MA : WS_MB))); const int t = isga ? pn - 8 : ((pn - 28) & 3);
            const int cb = t * 256 + 64 * wc + 8 * fq;
#pragma unroll
            for (int ai = 0; ai < 2; ++ai)
#pragma unroll
                for (int m = 0; m < 4; ++m) {
                    bf16_t* rowp = O + (size_t)(rowb + ai * 128 + m * 16) * DM + cb; const float rsv = row_rstd(part, rowb + ai * 128 + m * 16);
                    const float nr = -LOG2E * rsv;
                    if (isga) {
#pragma unroll
                        for (int bj = 0; bj < 2; ++bj) { f32x4 a, b;
#pragma unroll
                            for (int e = 0; e < 4; ++e) { const float xa = acc[ai][bj][m][0][e], xb = acc[ai][bj][m][1][e];
                                a[e] = (xa * rsv) * fast_rcp(1.f + __builtin_amdgcn_exp2f(xa * nr)); b[e] = (xb * rsv) * fast_rcp(1.f + __builtin_amdgcn_exp2f(xb * nr)); }
                            u32x4 w; w.x = pkbf(a[0], a[1]); w.y = pkbf(a[2], a[3]); w.z = pkbf(b[0], b[1]); w.w = pkbf(b[2], b[3]); *(u32x4*)(rowp + 32 * bj) = w; }
                    } else {
#pragma unroll
                        for (int bj = 0; bj < 2; ++bj) { f32x4 a, b;
#pragma unroll
                            for (int e = 0; e < 4; ++e) { a[e] = fast_rcp(1.f + __builtin_amdgcn_exp2f(acc[ai][bj][m][0][e] * nr)); b[e] = fast_rcp(1.f + __builtin_amdgcn_exp2f(acc[ai][bj][m][1][e] * nr)); }
                            u32x4 w; w.x = pkbf(a[0], a[1]); w.y = pkbf(a[2], a[3]); w.z = pkbf(b[0], b[1]); w.w = pkbf(b[2], b[3]); *(u32x4*)(rowp + 32 * bj) = w; }
                    }
                }
        }
    }
};
struct EpiVT {
    static constexpr bool PERM = true, AFTER_DRAIN = false;
    const float* part; unsigned char* wsb;
    __device__ __forceinline__ void operator()(const f32x4 (&acc)[2][2][4][2], const pg8::Unit& u, int wr, int wc, int fr, int fq) const {
        const int cb = u.pn * 256 + 32 * wc + 8 * fq, rowb = u.pm * 256 + wr * 64 + fr;
        f32x4 rs[2][2];
#pragma unroll
        for (int bj = 0; bj < 2; ++bj)
#pragma unroll
            for (int n = 0; n < 2; ++n)
#pragma unroll
                for (int e = 0; e < 4; ++e) rs[bj][n][e] = row_rstd(part, cb + 128 * bj + 4 * n + e);
#pragma unroll
        for (int ai = 0; ai < 2; ++ai)
#pragma unroll
            for (int m = 0; m < 4; ++m) { bf16_t* rowp = (bf16_t*)(wsb + WS_VT) + (size_t)(rowb + ai * 128 + m * 16) * MC + cb;
#pragma unroll
                for (int bj = 0; bj < 2; ++bj) { const f32x4 a = acc[ai][bj][m][0] * rs[bj][0], b = acc[ai][bj][m][1] * rs[bj][1];
                    u32x4 w; w.x = pkbf(a[0], a[1]); w.y = pkbf(a[2], a[3]); w.z = pkbf(b[0], b[1]); w.w = pkbf(b[2], b[3]); *(u32x4*)(rowp + 128 * bj) = w; } }
    }
};
template <int MODE> struct EpiGate {
    static constexpr bool PERM = true, AFTER_DRAIN = false;
    unsigned char* wsb;
    __device__ __forceinline__ void operator()(const f32x4 (&acc)[2][2][4][2], const pg8::Unit& u, int wr, int wc, int fr, int fq) const {
        const int cb = u.pn * 256 + 32 * wc + 8 * fq, rowb = u.pm * 256 + wr * 64 + fr;
        const bf16_t* G = (const bf16_t*)(wsb + (MODE ? WS_MB : WS_MA)); const bf16_t* Tin = (const bf16_t*)(wsb + WS_U); bf16_t* O = (bf16_t*)(wsb + (MODE ? WS_W : WS_U));
#pragma unroll
        for (int ai = 0; ai < 2; ++ai)
#pragma unroll
            for (int m = 0; m < 4; ++m) { const size_t off = (size_t)(rowb + ai * 128 + m * 16) * DM + cb;
#pragma unroll
                for (int bj = 0; bj < 2; ++bj) { const u32x4 g = *(const u32x4*)(G + off + 128 * bj); const f32x4 a = acc[ai][bj][m][0], b = acc[ai][bj][m][1];
                    float r[8] = {a[0] * bflo(g.x), a[1] * bfhi(g.x), a[2] * bflo(g.y), a[3] * bfhi(g.y), b[0] * bflo(g.z), b[1] * bfhi(g.z), b[2] * bflo(g.w), b[3] * bfhi(g.w)};
                    if (MODE == 1) { const u32x4 t = *(const u32x4*)(Tin + off + 128 * bj);
                        r[0] += bflo(t.x); r[1] += bfhi(t.x); r[2] += bflo(t.y); r[3] += bfhi(t.y); r[4] += bflo(t.z); r[5] += bfhi(t.z); r[6] += bflo(t.w); r[7] += bfhi(t.w); }
                    u32x4 w; w.x = pkbf(r[0], r[1]); w.y = pkbf(r[2], r[3]); w.z = pkbf(r[4], r[5]); w.w = pkbf(r[6], r[7]); *(u32x4*)(O + off + 128 * bj) = w; } }
    }
};
struct EpiOut {
    static constexpr bool PERM = true, AFTER_DRAIN = false;
    const float* xin; float* xout; bf16_t* XB; float* part;
    __device__ __forceinline__ void operator()(const f32x4 (&acc)[2][2][4][2], const pg8::Unit& u, int wr, int wc, int fr, int fq) const {
        const int cb = u.pn * 256 + 32 * wc + 8 * fq, rowb = u.pm * 256 + wr * 64 + fr;
#pragma unroll
        for (int ai = 0; ai < 2; ++ai)
#pragma unroll
            for (int m = 0; m < 4; ++m) { const int row = rowb + ai * 128 + m * 16; const size_t off = (size_t)row * DM + cb; float ss = 0.f;
#pragma unroll
                for (int bj = 0; bj < 2; ++bj) { const f32x4 a = acc[ai][bj][m][0] + ld4(xin + off + 128 * bj), b = acc[ai][bj][m][1] + ld4(xin + off + 128 * bj + 4);
                    *(f32x4*)(xout + off + 128 * bj) = a; *(f32x4*)(xout + off + 128 * bj + 4) = b;
                    u32x4 w; w.x = pkbf(a[0], a[1]); w.y = pkbf(a[2], a[3]); w.z = pkbf(b[0], b[1]); w.w = pkbf(b[2], b[3]); *(u32x4*)(XB + off + 128 * bj) = w;
                    const f32x4 qa = a * a, qb = b * b; ss += ((qa[0] + qa[1]) + (qa[2] + qa[3])) + ((qb[0] + qb[1]) + (qb[2] + qb[3])); }
                ss += __shfl_xor(ss, 16); ss += __shfl_xor(ss, 32);
                if (fq == 0) part[(size_t)row * 16 + u.pn * 4 + wc] = ss; }
    }
};

template <class E0, class E1> struct EpiDual {
    static constexpr bool PERM = true, AFTER_DRAIN = false;
    E0 e0; E1 e1;
    __device__ __forceinline__ void operator()(const f32x4 (&acc)[2][2][4][2], const pg8::Unit& u, int wr, int wc, int fr, int fq) const { if (u.w) e1(acc, u, wr, wc, fr, fq); else e0(acc, u, wr, wc, fr, fq); }
};
namespace att {
constexpr int KP = 256, VP = 128, KBY = 64 * KP, VBY = 128 * VP;
constexpr int OFF_TAB = 69632, OFF_L = OFF_TAB + 2560, XP = 132;
__device__ __forceinline__ int crow(int r, int hi) { return (r & 3) + 8 * (r >> 2) + 4 * hi; }
__device__ __forceinline__ bf16x8 pack8(const f32x16& p, int b) {
    u32x4 w; w.x = pkbf(p[b], p[b + 1]); w.y = pkbf(p[b + 2], p[b + 3]); w.z = pkbf(p[b + 4], p[b + 5]); w.w = pkbf(p[b + 6], p[b + 7]); return __builtin_bit_cast(bf16x8, w); }
__device__ __forceinline__ void attn_unit(LAS unsigned char* lds, const bf16_t* Q, const bf16_t* K, const bf16_t* VT, const bf16_t* GA, bf16_t* O, const float* tabg,
                                          float lam, const float* subg, float osc, int seq, int h, int qb, int rot) {
    int tid_l = threadIdx.x; asm volatile("" : "+v"(tid_l));
    const int tid = tid_l, lane = tid & 63, r32 = lane & 31, hi = lane >> 5, wid = __builtin_amdgcn_readfirstlane(tid >> 6), sm = wid >> 2, qg = wid & 3;
    const int tok0 = seq * SEQL, q0 = qb * 128;
    LAS float* tabl = (LAS float*)(lds + OFF_TAB);
    for (int i = tid; i < TABN; i += 512) tabl[i] = tabg[i];
    const float b_lo = tabg[0], b_hi = tabg[TABN - 1];
    bf16x8 qf[4];
    { const bf16_t* qp = Q + (size_t)(tok0 + q0 + qg * 32 + r32) * DM + h * 128 + sm * 64 + hi * 8;
#pragma unroll
      for (int d0 = 0; d0 < 4; ++d0) qf[d0] = *(const bf16x8*)(qp + d0 * 16); }
    const bf16_t* kg[2]; const bf16_t* vg[2];
#pragma unroll
    for (int i = 0; i < 2; ++i) { const int pc = 2 * wid + i;
        { const int row = 4 * pc + (lane >> 4), c = (lane & 15) ^ (row & 15); kg[i] = K + (size_t)(tok0 + row) * DM + h * 128 + c * 8; }
        { const int row = 8 * pc + (lane >> 3), c = (lane & 7) ^ ((row >> 1) & 7); vg[i] = VT + (size_t)(h * 128 + row) * MC + tok0 + c * 8; } }
#define ATT_DMA_K(tile, kbo) do { _Pragma("unroll") for (int i = 0; i < 2; ++i) \
        __builtin_amdgcn_global_load_lds((const unsigned*)(kg[i] + (size_t)(tile) * 64 * DM), (LAS unsigned*)(lds + (kbo) + (2 * wid + i) * 1024), 16, 0, 0); } while (0)
#define ATT_DMA_V(tile, vbo) do { _Pragma("unroll") for (int i = 0; i < 2; ++i) \
        __builtin_amdgcn_global_load_lds((const unsigned*)(vg[i] + (tile) * 64), (LAS unsigned*)(lds + 2 * KBY + (vbo) + (2 * wid + i) * 1024), 16, 0, 0); } while (0)
    ATT_DMA_K(rot, 0); ATT_DMA_V(rot, 0); ATT_DMA_K((rot + 1) & 63, KBY);
    asm volatile("s_waitcnt vmcnt(0)" ::: "memory");
    __syncthreads();
    f32x16 o[4];
#pragma unroll
    for (int d0 = 0; d0 < 4; ++d0)
#pragma unroll
        for (int r = 0; r < 16; ++r) o[d0][r] = 0.f;
    float l = 0.f; int cc = 1;
    const int kact = (r32 & 19) | ((r32 & 4) << 1) | ((r32 & 8) >> 1);
    int kofs[4], vofs[4];
#pragma unroll
    for (int d0 = 0; d0 < 4; ++d0) { kofs[d0] = kact * KP + (((sm * 8 + 2 * d0 + hi) ^ (kact & 15)) << 4); vofs[d0] = 2 * KBY + r32 * VP + (((2 * d0 + hi) ^ ((r32 >> 1) & 7)) << 4); }
    const int qpos = q0 + qg * 32 + r32;
#define ATT_CLASS(k0) (((k0) + 63 <= q0 + qg * 32 - 91) ? 0 : (((k0) >= q0 + qg * 32 + 31 + 91) ? 2 : 1))
#define ATT_EV(c) ((c) == 0 ? b_lo : ((c) == 2 ? b_hi : 0.f))
#define ATT_SBAR() __builtin_amdgcn_sched_barrier(0)
#define ATT_EXP4(P, b) do { P[(b)] = __builtin_amdgcn_exp2f(P[(b)]); P[(b) + 1] = __builtin_amdgcn_exp2f(P[(b) + 1]); P[(b) + 2] = __builtin_amdgcn_exp2f(P[(b) + 2]); P[(b) + 3] = __builtin_amdgcn_exp2f(P[(b) + 3]); } while (0)
#define ATT_S01(N0, N1, k0, a0_, a1_) do { \
        if (ATT_CLASS(k0) == 1) { \
            const LAS float* tb_ = tabl + ((k0) + 8 * hi - qpos + TABZ);     \
            _Pragma("unroll") for (int r = 0; r < 16; ++r) { N0[r] = tb_[16 * (r >> 3) + (r & 7)]; N1[r] = tb_[16 * (r >> 3) + (r & 7) + 32]; } \
            N0 = __builtin_amdgcn_mfma_f32_32x32x16_bf16(a0_, qf[0], N0, 0, 0, 0); N1 = __builtin_amdgcn_mfma_f32_32x32x16_bf16(a1_, qf[0], N1, 0, 0, 0); \
        } else { const f32x16 z_ = {0.f, 0.f, 0.f, 0.f, 0.f, 0.f, 0.f, 0.f, 0.f, 0.f, 0.f, 0.f, 0.f, 0.f, 0.f, 0.f}; \
            N0 = __builtin_amdgcn_mfma_f32_32x32x16_bf16(a0_, qf[0], z_, 0, 0, 0); N1 = __builtin_amdgcn_mfma_f32_32x32x16_bf16(a1_, qf[0], z_, 0, 0, 0); } } while (0)
#define ATT_STEP(C0, C1, N0, N1, T) do { \
        const int t_ = (T), k0_ = ((t_ + rot) & 63) * 64, k1_ = ((t_ + 1 + rot) & 63) * 64; \
        { const int cn_ = ATT_CLASS(k0_); if (cn_ != cc) { const float sc = __builtin_amdgcn_exp2f(ATT_EV(cc) - ATT_EV(cn_)); \
            _Pragma("unroll") for (int d0 = 0; d0 < 4; ++d0) o[d0] = o[d0] * sc; \
            l *= sc; cc = cn_; } } \
        const LAS unsigned char* kb = lds + ((t_ + 1) & 1) * KBY; \
        { bf16x8 ka0_ = *(const LAS bf16x8*)(kb + kofs[0]), ka1_ = *(const LAS bf16x8*)(kb + kofs[0] + 32 * KP); bf16x8 ka[6]; \
          _Pragma("unroll") for (int d0 = 1; d0 < 4; ++d0) { ka[2 * d0 - 2] = *(const LAS bf16x8*)(kb + kofs[d0]); ka[2 * d0 - 1] = *(const LAS bf16x8*)(kb + kofs[d0] + 32 * KP); } \
          ATT_EXP4(C0, 0); ATT_EXP4(C1, 0); \
          ATT_SBAR(); \
          ATT_S01(N0, N1, k1_, ka0_, ka1_); \
          ATT_SBAR(); \
          _Pragma("unroll") for (int d0 = 1; d0 < 4; ++d0) { \
              N0 = __builtin_amdgcn_mfma_f32_32x32x16_bf16(ka[2 * d0 - 2], qf[d0], N0, 0, 0, 0); ATT_EXP4(C0, 4 * d0); \
              N1 = __builtin_amdgcn_mfma_f32_32x32x16_bf16(ka[2 * d0 - 1], qf[d0], N1, 0, 0, 0); ATT_EXP4(C1, 4 * d0); } \
          _Pragma("unroll") for (int g_ = 0; g_ < 6; ++g_) { __builtin_amdgcn_sched_group_barrier(0x008, 1, 0); __builtin_amdgcn_sched_group_barrier(0x400, 4, 0); } } \
        ATT_SBAR(); \
        ATT_DMA_K((t_ + 2 + rot) & 63, (t_ & 1) * KBY); ATT_DMA_V((t_ + 1 + rot) & 63, ((t_ + 1) & 1) * VBY);     \
        { bf16x8 pa[4]; pa[0] = pack8(C0, 0); pa[1] = pack8(C0, 8); pa[2] = pack8(C1, 0); pa[3] = pack8(C1, 8); \
          { float s_[4]; \
            _Pragma("unroll") for (int r = 0; r < 4; ++r) s_[r] = C0[r] + C1[r]; \
            _Pragma("unroll") for (int r = 4; r < 16; ++r) s_[r & 3] += C0[r] + C1[r]; \
            l += (s_[0] + s_[1]) + (s_[2] + s_[3]); } \
          ATT_SBAR(); \
          const LAS unsigned char* vb = lds + (t_ & 1) * VBY; \
          bf16x8 v0[4], v1[4]; \
          _Pragma("unroll") for (int d0 = 0; d0 < 4; ++d0) v0[d0] = *(const LAS bf16x8*)(vb + vofs[0] + d0 * 32 * VP); \
          _Pragma("unroll") for (int d0 = 0; d0 < 4; ++d0) v1[d0] = *(const LAS bf16x8*)(vb + vofs[1] + d0 * 32 * VP); \
          _Pragma("unroll") for (int d0 = 0; d0 < 4; ++d0) o[d0] = __builtin_amdgcn_mfma_f32_32x32x16_bf16(pa[0], v0[d0], o[d0], 0, 0, 0); \
          _Pragma("unroll") for (int d0 = 0; d0 < 4; ++d0) v0[d0] = *(const LAS bf16x8*)(vb + vofs[2] + d0 * 32 * VP); \
          _Pragma("unroll") for (int d0 = 0; d0 < 4; ++d0) o[d0] = __builtin_amdgcn_mfma_f32_32x32x16_bf16(pa[1], v1[d0], o[d0], 0, 0, 0); \
          _Pragma("unroll") for (int d0 = 0; d0 < 4; ++d0) v1[d0] = *(const LAS bf16x8*)(vb + vofs[3] + d0 * 32 * VP); \
          _Pragma("unroll") for (int d0 = 0; d0 < 4; ++d0) o[d0] = __builtin_amdgcn_mfma_f32_32x32x16_bf16(pa[2], v0[d0], o[d0], 0, 0, 0); \
          _Pragma("unroll") for (int d0 = 0; d0 < 4; ++d0) o[d0] = __builtin_amdgcn_mfma_f32_32x32x16_bf16(pa[3], v1[d0], o[d0], 0, 0, 0); \
          __builtin_amdgcn_sched_group_barrier(0x100, 8, 0); \
          _Pragma("unroll") for (int j = 0; j < 8; ++j) { __builtin_amdgcn_sched_group_barrier(0x008, 1, 0); __builtin_amdgcn_sched_group_barrier(0x100, 1, 0); } \
          __builtin_amdgcn_sched_group_barrier(0x008, 8, 0); } \
        ATT_SBAR(); \
        asm volatile("s_waitcnt vmcnt(0)" ::: "memory"); \
        __syncthreads(); \
    } while (0)
    f32x16 pA0, pA1, pB0, pB1;
    {
        const LAS unsigned char* kb = lds; const int k00 = rot * 64;
        const bf16x8 b0_ = *(const LAS bf16x8*)(kb + kofs[0]), b1_ = *(const LAS bf16x8*)(kb + kofs[0] + 32 * KP);
        ATT_S01(pA0, pA1, k00, b0_, b1_);
#pragma unroll
        for (int d0 = 1; d0 < 4; ++d0) { const bf16x8 a0 = *(const LAS bf16x8*)(kb + kofs[d0]), a1 = *(const LAS bf16x8*)(kb + kofs[d0] + 32 * KP);
            pA0 = __builtin_amdgcn_mfma_f32_32x32x16_bf16(a0, qf[d0], pA0, 0, 0, 0); pA1 = __builtin_amdgcn_mfma_f32_32x32x16_bf16(a1, qf[d0], pA1, 0, 0, 0); }
    }
    __syncthreads();
    for (int t = 0; t < 64; t += 2) {
        ATT_STEP(pA0, pA1, pB0, pB1, t);
        ATT_STEP(pB0, pB1, pA0, pA1, t + 1);
    }
#undef ATT_STEP
#undef ATT_DMA_K
#undef ATT_DMA_V
#undef ATT_S01
#undef ATT_EXP4
#undef ATT_SBAR
#undef ATT_CLASS
#undef ATT_EV
    l += __shfl_xor(l, 32);
    LAS float* Ls = (LAS float*)(lds + OFF_L) + wid * 32;
    if (hi == 0) Ls[r32] = l;
    asm volatile("s_waitcnt lgkmcnt(0)" ::: "memory");
    float inv[16];
#pragma unroll
    for (int r = 0; r < 16; ++r) inv[r] = (sm ? lam : 1.f) * fast_rcp(Ls[crow(r, hi)]);
    LAS float* X = (LAS float*)lds + qg * (32 * XP);
    if (sm == 1) {
#pragma unroll
        for (int d0 = 0; d0 < 4; ++d0)
#pragma unroll
            for (int r = 0; r < 16; ++r) X[crow(r, hi) * XP + d0 * 32 + r32] = o[d0][r] * inv[r];
    }
    __syncthreads();
    if (sm == 0) {
#pragma unroll
        for (int d0 = 0; d0 < 4; ++d0)
#pragma unroll
            for (int r = 0; r < 16; ++r) { const int ix = crow(r, hi) * XP + d0 * 32 + r32; X[ix] = o[d0][r] * inv[r] - X[ix]; }
        asm volatile("s_waitcnt lgkmcnt(0)" ::: "memory");
        const LAS float* xr = X + r32 * XP + hi * 64;
        f32x4 xv[16]; float ss = 0.f;
#pragma unroll
        for (int j = 0; j < 16; ++j) { xv[j] = *(const LAS f32x4*)(xr + 4 * j); const f32x4 q = xv[j] * xv[j]; ss += (q[0] + q[1]) + (q[2] + q[3]); }
        ss += __shfl_xor(ss, 32);
        const float rstd = __builtin_amdgcn_rsqf(ss * (1.0f / 128.0f) + EPS) * osc;
        const size_t off = (size_t)(tok0 + q0 + qg * 32 + r32) * DM + h * 128 + hi * 64;
#pragma unroll
        for (int j = 0; j < 8; ++j) { const u32x4 g = *(const u32x4*)(GA + off + 8 * j); const f32x4 s0 = ld4(subg + hi * 64 + 8 * j), s1 = ld4(subg + hi * 64 + 8 * j + 4);
            const f32x4 a = xv[2 * j] * rstd * s0, b = xv[2 * j + 1] * rstd * s1;
            u32x4 w; w.x = pkbf(a[0] * bflo(g.x), a[1] * bfhi(g.x)); w.y = pkbf(a[2] * bflo(g.y), a[3] * bfhi(g.y)); w.z = pkbf(b[0] * bflo(g.z), b[1] * bfhi(g.z)); w.w = pkbf(b[2] * bflo(g.w), b[3] * bfhi(g.w));
            *(u32x4*)(O + off + 8 * j) = w; }
    }
    __syncthreads();
}
}
__device__ __forceinline__ unsigned f2bf(float f) { unsigned u = __builtin_bit_cast(unsigned, f); return (u + 0x7fffu + ((u >> 16) & 1u)) >> 16; }
__device__ __forceinline__ unsigned pk2(float lo, float hi) { return f2bf(lo) | (f2bf(hi) << 16); }
__device__ __forceinline__ int win_srccol(int gr) {
    const int pn = gr >> 8, gc = gr & 255, bj = gc >> 7, wc = (gc >> 5) & 3, j = gc & 31, lc = 64 * wc + 32 * bj + j;
    if (pn < 4) return 256 * pn + lc;
    if (pn < 8) return 1024 + 256 * (pn - 4) + lc;
    if (pn < 12) return 3072 + 256 * (pn - 8) + lc;
    if (pn < 28) { const int fq = (j >> 3) & 3, n = (j >> 2) & 1, e = j & 3; return 4096 + (2 * bj + n) * 1024 + 64 * (pn - 12) + 16 * wc + 4 * fq + e; }
    if (pn < 32) return 8192 + 256 * (pn - 28) + lc;
    return 9216 + 256 * (pn - 32) + lc;
}
__device__ __forceinline__ void tr_item(const float* W, int ldw, const float* gf, bf16_t* WT, int kind, int coff, int n0, int k0, LAS float* scr, int lane) {
    const int n4 = lane & 7, kr = lane >> 3, src = kind ? win_srccol(n0 + 4 * n4) : coff + n0 + 4 * n4;
#pragma unroll
    for (int i = 0; i < 8; ++i) { const int kk = 8 * i + kr; f32x4 v = ld4(W + (size_t)(k0 + kk) * ldw + src); if (gf) v = v * gf[k0 + kk];
        scr[kk * 33 + 4 * n4] = v[0]; scr[kk * 33 + 4 * n4 + 1] = v[1]; scr[kk * 33 + 4 * n4 + 2] = v[2]; scr[kk * 33 + 4 * n4 + 3] = v[3]; }
    asm volatile("s_waitcnt lgkmcnt(0)" ::: "memory");
    const int c = lane & 7;
#pragma unroll
    for (int j = 0; j < 4; ++j) { const int n = (lane >> 3) + 8 * j; const LAS float* s = scr + (8 * c) * 33 + n;
        u32x4 o; o.x = pk2(s[0 * 33], s[1 * 33]); o.y = pk2(s[2 * 33], s[3 * 33]); o.z = pk2(s[4 * 33], s[5 * 33]); o.w = pk2(s[6 * 33], s[7 * 33]);
        *(u32x4*)(WT + (size_t)(n0 + n) * DM + k0 + 8 * c) = o; }
    asm volatile("s_waitcnt lgkmcnt(0)" ::: "memory");
}
__device__ __forceinline__ float wave_sum(float v) {
#pragma unroll
    for (int o = 1; o < 64; o <<= 1) v += __shfl_xor(v, o);
    return v;
}
__device__ __forceinline__ int rel_bucket(int rel) {
    const int n = rel < 0 ? -rel : rel; int b;
    if (n < 8) b = n; else if (n < 12) b = 8; else if (n < 16) b = 9; else if (n < 23) b = 10; else if (n < 32) b = 11; else if (n < 46) b = 12; else if (n < 64) b = 13; else if (n < 91) b = 14; else b = 15;
    return (rel > 0 ? 16 : 0) + b;
}

#define XB_TMO      128
#define XB_XCNT(j)  (256  + 64 * (j))
#define XB_XSUB(j)  (1280 + 64 * (j))
#define XB_XGEN(j)  (2304 + 64 * (j))
#define XB_TOP      3328
#define XB_TOPGEN   3392
#define XCD_BAR_WORDS 3456
#define XB_SPIN_CAP (1u << 18)

__device__ __forceinline__ unsigned xb_ld(unsigned* p)              { return __hip_atomic_load(p, __ATOMIC_RELAXED, __HIP_MEMORY_SCOPE_AGENT); }
__device__ __forceinline__ unsigned xb_add(unsigned* p, unsigned v) { return __hip_atomic_fetch_add(p, v, __ATOMIC_RELAXED, __HIP_MEMORY_SCOPE_AGENT); }
__device__ __forceinline__ unsigned xb_xcc_id() { return (unsigned)__builtin_amdgcn_s_getreg((3 << 11) | 20) & 0xFu; }
#define XB_SPIN(cond, bar) do { unsigned _sp = 0; while (cond) { __builtin_amdgcn_s_sleep(1); \
    if ((++_sp & 255u) == 0u) { if (xb_ld(&(bar)[XB_TMO])) break; if (_sp > XB_SPIN_CAP) { atomicAdd(&(bar)[XB_TMO], 1u); break; } } } } while (0)

struct XcdBarrier {
    unsigned* bar; unsigned x;
    volatile LAS unsigned* st;
};

__device__ __forceinline__ XcdBarrier xcd_barrier_post(unsigned* bar, volatile LAS unsigned* st) {
    XcdBarrier b; b.bar = bar; b.x = xb_xcc_id(); b.st = st;
    if (threadIdx.x == 0) (void)xb_add(&bar[XB_XCNT(b.x)], 1u);
    return b;
}
__device__ __forceinline__ void xcd_barrier_complete(unsigned* bar, unsigned x, unsigned& nloc, unsigned& nx) {
    const unsigned G = gridDim.x * gridDim.y * gridDim.z;
    unsigned sum, cnt, mine, sp = 0u;
    for (;;) {
        sum = 0u; cnt = 0u; mine = 0u;
#pragma unroll
        for (unsigned j = 0; j < 16; ++j) { const unsigned c = xb_ld(&bar[XB_XCNT(j)]); sum += c; cnt += (c > 0u) ? 1u : 0u; mine = (j == x) ? c : mine; }
        if (sum == G) break;
        __builtin_amdgcn_s_sleep(1);
        if ((++sp & 255u) == 0u) { if (xb_ld(&bar[XB_TMO])) break; if (sp > XB_SPIN_CAP) { atomicAdd(&bar[XB_TMO], 1u); break; } }
    }
    nloc = mine > 0u ? mine : 1u; nx = cnt > 0u ? cnt : 1u;
}

__device__ __forceinline__ void xcd_barrier(const XcdBarrier& b) {
    asm volatile("s_waitcnt vmcnt(0)" ::: "memory");
    __syncthreads();
    if (threadIdx.x == 0) {
        unsigned* bar = b.bar;
        __builtin_amdgcn_s_waitcnt(0);
        unsigned nloc = b.st[0], nx = b.st[1];
        if (nloc == 0u) { xcd_barrier_complete(bar, b.x, nloc, nx); b.st[0] = nloc; b.st[1] = nx; }
        const unsigned old = xb_add(&bar[XB_XSUB(b.x)], 1u);
        const unsigned gen = old / nloc;
        if (old + 1u == (gen + 1u) * nloc) {
            __builtin_amdgcn_fence(__ATOMIC_RELEASE, "agent");
            asm volatile("s_waitcnt vmcnt(0)" ::: "memory");
            const unsigned og = xb_add(&bar[XB_TOP], 1u);
            const unsigned tg = og / nx;
            if (og + 1u == (tg + 1u) * nx) xb_add(&bar[XB_TOPGEN], 1u);
            else XB_SPIN(xb_ld(&bar[XB_TOPGEN]) == tg, bar);
            __builtin_amdgcn_fence(__ATOMIC_ACQUIRE, "agent");
            xb_add(&bar[XB_XGEN(b.x)], 1u);
            asm volatile("s_waitcnt vmcnt(0)" ::: "memory");
        } else {
            XB_SPIN(xb_ld(&bar[XB_XGEN(b.x)]) == gen, bar);
            __builtin_amdgcn_fence(__ATOMIC_ACQUIRE, "agent");
            asm volatile("s_waitcnt vmcnt(0)" ::: "memory");
        }
    }
    __syncthreads();
}

constexpr size_t WS_BAR = 65536;
struct Args { const float* in[16]; float* out; unsigned char* ws; };

__global__ void __launch_bounds__(512, 2) fwd_kernel(Args a) {
    extern __shared__ __attribute__((aligned(16))) unsigned char lds_raw[];
    LAS unsigned char* lds = (LAS unsigned char*)lds_raw;
    cgx::grid_group grid = cgx::this_grid();
    const int tid = threadIdx.x, lane = tid & 63, wave = __builtin_amdgcn_readfirstlane(tid >> 6);
    const int G = gridDim.x, bid = blockIdx.x;
    volatile LAS unsigned* bst = (volatile LAS unsigned*)(lds + 131072 + 320);
    if (tid < 2) bst[tid] = 0u;
    __syncthreads();
    const XcdBarrier bar = xcd_barrier_post((unsigned*)(a.ws + WS_BAR), bst);
#define WSL() ({ size_t z_ = 0; asm volatile("" : "+s"(z_)); a.ws + z_; })
#define PTR(T, base, off) ((T*)((base) + (off)))
    {
        const float *x_prompt = a.in[0], *x_sample = a.in[1], *rel_bias = a.in[2], *norm_g = a.in[3], *w_in = a.in[4], *lq1 = a.in[7], *lk1 = a.in[8], *lq2 = a.in[9], *lk2 = a.in[10], *w_attn_out = a.in[12], *w_conv_out = a.in[14], *w_o = a.in[15];
        unsigned char* wsp = WSL();
        float* misc = PTR(float, wsp, WS_MISC); float* part_all = PTR(float, wsp, WS_PART);
        bf16_t *WinT = PTR(bf16_t, wsp, WS_WIN), *WvT = PTR(bf16_t, wsp, WS_WV), *WaT = PTR(bf16_t, wsp, WS_WA), *WbT = PTR(bf16_t, wsp, WS_WB), *WoT = PTR(bf16_t, wsp, WS_WO), *XB_all = PTR(bf16_t, wsp, WS_XB);
        LAS float* scr = (LAS float*)(lds + wave * 8704);
        const int gw = bid * 8 + wave, NGW = G * 8;
        constexpr int IPL = 16 * ((NIN + 4 * 1024) / 32);
        for (int it = gw; it < DEPTH * IPL; it += NGW) {
            const int l = it / IPL, r = it % IPL, kb = r & 15; int nb = r >> 4;
            if (nb < NIN / 32) { tr_item(w_in + (size_t)l * DM * NPROJ, NPROJ, norm_g + l * DM, WinT + (size_t)l * NIN * DM, 1, 0, nb * 32, kb * 64, scr, lane); continue; } nb -= NIN / 32;
            if (nb < 32) { tr_item(w_in + (size_t)l * DM * NPROJ, NPROJ, norm_g + l * DM, WvT + (size_t)l * DM * DM, 0, 2048, nb * 32, kb * 64, scr, lane); continue; } nb -= 32;
            if (nb < 32) { tr_item(w_attn_out + (size_t)l * DM * DM, DM, nullptr, WaT + (size_t)l * DM * DM, 0, 0, nb * 32, kb * 64, scr, lane); continue; } nb -= 32;
            if (nb < 32) { tr_item(w_conv_out + (size_t)l * DM * DM, DM, nullptr, WbT + (size_t)l * DM * DM, 0, 0, nb * 32, kb * 64, scr, lane); continue; } nb -= 32;
            tr_item(w_o + (size_t)l * DM * DM, DM, nullptr, WoT + (size_t)l * DM * DM, 0, 0, nb * 32, kb * 64, scr, lane);
        }
#pragma unroll 2
        for (int m = gw; m < MTOT; m += NGW) {
            const float* xrow = (m < 8 * SEQL) ? x_prompt + (size_t)m * DM : x_sample + (size_t)(m - 8 * SEQL) * DM;
            f32x4 v[4]; float s = 0.f;
#pragma unroll
            for (int j = 0; j < 4; ++j) { v[j] = ld4(xrow + 4 * lane + 256 * j); const f32x4 q = v[j] * v[j]; s += (q[0] + q[1]) + (q[2] + q[3]); }
            s = wave_sum(s);
            u32x2* o8 = (u32x2*)(XB_all + (size_t)m * DM) + lane;
#pragma unroll
            for (int j = 0; j < 4; ++j) { u32x2 w; w.x = pk2(v[j][0], v[j][1]); w.y = pk2(v[j][2], v[j][3]); o8[64 * j] = w; }
            if (lane < 16) part_all[(size_t)m * 16 + lane] = (lane == 0) ? s : 0.f;
        }
        if (bid == 0) {
            if (tid < DEPTH) { float s1 = 0.f, s2 = 0.f; for (int i = 0; i < 64; ++i) { s1 += lq1[tid * 64 + i] * lk1[tid * 64 + i]; s2 += lq2[tid * 64 + i] * lk2[tid * 64 + i]; }
                misc[tid] = expf(s1) - expf(s2) + (0.8f - 0.6f * expf(-0.3f * (float)tid)); }
            for (int i = tid; i < 8 * TABN; i += 512) { const int h = i / TABN, j = i % TABN; const int rel = j - TABZ; misc[64 + i] = rel_bias[rel_bucket(rel) * 8 + h] * LOG2E; }
        }
    }
    grid.sync();

    for (int c = 0; c < NCHUNK; ++c) {
        for (int l = 0; l < DEPTH; ++l) {
            {
                unsigned char* wsp = WSL(); bf16_t* XB = PTR(bf16_t, wsp, WS_XB) + (size_t)c * MC * DM; const float* part = PTR(float, wsp, WS_PART) + (size_t)c * MC * 16;
                pg8::Gemm g{XB, PTR(bf16_t, wsp, WS_WIN) + (size_t)l * NIN * DM, MC, NIN, DM, PTR(bf16_t, wsp, WS_WV) + (size_t)l * DM * DM, XB};
                pg8::DualOrder S; S.s0.init(MC, NIN, G, bid); S.s1.init(DM, MC, G, bid); S.G = G; S.c = bid;
                typedef EpiDual<EpiInProj, EpiVT> EP;
                EP E{EpiInProj{part, wsp, a.in[5] + l * 64, a.in[6] + l * 64, a.in[13] + (size_t)l * 3 * DM}, EpiVT{part, wsp}};
                pg8::gemm_phase<EP, pg8::DualOrder, true, true>(lds, g, S, E);
            }
            xcd_barrier(bar);
            {
                unsigned char* wsp = WSL(); const float* misc = PTR(float, wsp, WS_MISC);
                bf16_t *Qb = PTR(bf16_t, wsp, WS_Q), *Kb = PTR(bf16_t, wsp, WS_K), *VTb = PTR(bf16_t, wsp, WS_VT), *GAb = PTR(bf16_t, wsp, WS_GA), *Ub = PTR(bf16_t, wsp, WS_U), *Wb = PTR(bf16_t, wsp, WS_W), *BCb = PTR(bf16_t, wsp, WS_BC);
                const float* cw = a.in[13] + (size_t)l * 3 * DM; const float* subln_g = a.in[11];
                int tid_c = threadIdx.x; asm volatile("" : "+v"(tid_c));
                for (int it = bid * 512 + tid_c; it < (MC / 64) * 2 * 128; it += G * 512) {
                    const int c8 = (it & 127) * 8, j = it >> 7, row = (j >> 1) * 64 + ((j & 1) ? 63 : 0);
                    const size_t off = (size_t)row * DM + c8;
                    const u32x4 z4 = (u32x4){0u, 0u, 0u, 0u};
                    const u32x4 pv = ((row & (SEQL - 1)) != 0) ? *(const u32x4*)(Ub + off - DM) : z4, cv = *(const u32x4*)(Ub + off), nv = ((row & (SEQL - 1)) != SEQL - 1) ? *(const u32x4*)(Ub + off + DM) : z4, wv = *(const u32x4*)(Wb + off);
                    float res[8];
#pragma unroll
                    for (int e = 0; e < 4; ++e) {
                        res[2 * e] = bflo(wv[e]) * (cw[c8 + 2 * e] * bflo(pv[e]) + cw[DM + c8 + 2 * e] * bflo(cv[e]) + cw[2 * DM + c8 + 2 * e] * bflo(nv[e]));
                        res[2 * e + 1] = bfhi(wv[e]) * (cw[c8 + 2 * e + 1] * bfhi(pv[e]) + cw[DM + c8 + 2 * e + 1] * bfhi(cv[e]) + cw[2 * DM + c8 + 2 * e + 1] * bfhi(nv[e])); }
                    u32x4 o; o.x = pkbf(res[0], res[1]); o.y = pkbf(res[2], res[3]); o.z = pkbf(res[4], res[5]); o.w = pkbf(res[6], res[7]);
                    *(u32x4*)(BCb + off) = o;
                }
                const float lam = misc[l], osc = 1.0f - (0.8f - 0.6f * expf(-0.3f * (float)l));
                const int xcd = bid & 7, slot = bid >> 3, nslot = (G + 7) >> 3;
                for (int i = 0; i < (CH_SEQ * 8) / 8; ++i) {
                    const int p = 8 * i + xcd, seq = p >> 3, h = p & 7;
                    for (int qb = slot; qb < SEQL / 128; qb += nslot)
                        att::attn_unit(lds, Qb, Kb, VTb, GAb, Qb, misc + 64 + h * TABN, lam, subln_g + l * 128, osc, seq, h, qb, (2 * slot) & 63);
                }
            }
            xcd_barrier(bar);
            {
                unsigned char* wsp = WSL();
                pg8::Gemm g{PTR(bf16_t, wsp, WS_Q), PTR(bf16_t, wsp, WS_WA) + (size_t)l * DM * DM, MC, DM, DM, PTR(bf16_t, wsp, WS_BC), PTR(bf16_t, wsp, WS_WB) + (size_t)l * DM * DM};
                pg8::DualOrder S; S.s0.init(MC, DM, G, bid); S.s1.init(MC, DM, G, bid); S.G = G; S.c = bid;
                typedef EpiDual<EpiGate<0>, EpiGate<1>> EP;
                EP E{EpiGate<0>{wsp}, EpiGate<1>{wsp}};
                pg8::gemm_phase<EP, pg8::DualOrder, true, true>(lds, g, S, E);
            }
            xcd_barrier(bar);
            {
                unsigned char* wsp = WSL(); float* xo = a.out + (size_t)c * MC * DM; const float* xin0 = (c < 2) ? a.in[0] + (size_t)c * MC * DM : a.in[1];
                pg8::Gemm g{PTR(bf16_t, wsp, WS_W), PTR(bf16_t, wsp, WS_WO) + (size_t)l * DM * DM, MC, DM, DM, nullptr, nullptr}; pg8::StaticOrder S; S.init(MC, DM, G, bid);
                EpiOut E{l == 0 ? xin0 : xo, xo, PTR(bf16_t, wsp, WS_XB) + (size_t)c * MC * DM, PTR(float, wsp, WS_PART) + (size_t)c * MC * 16};
                pg8::gemm_phase<EpiOut, pg8::StaticOrder, true, true>(lds, g, S, E);
            }
            xcd_barrier(bar);
        }
    }
}

extern "C" void kernel_launch(void* const* d_in, const int* in_sizes, int n_in, void* d_out, int out_size, void* d_ws, size_t ws_size, hipStream_t stream) {
    static int grid = 0;
    if (grid == 0) {
        if (n_in != 16 || ws_size < WS_END) { fprintf(stderr, "kernel_launch: unexpected n_in %d or ws_size %zu (< %zu)\n", n_in, ws_size, (size_t)WS_END); grid = -1; return; }
        int dev = 0, cus = 0, per_cu = 0;
        hipGetDevice(&dev); hipDeviceGetAttribute(&cus, hipDeviceAttributeMultiprocessorCount, dev);
        if (hipFuncSetAttribute((const void*)fwd_kernel, hipFuncAttributeMaxDynamicSharedMemorySize, LDS_BYTES) != hipSuccess) { fprintf(stderr, "hipFuncSetAttribute failed\n"); grid = -1; return; }
        if (hipOccupancyMaxActiveBlocksPerMultiprocessor(&per_cu, (const void*)fwd_kernel, 512, LDS_BYTES) != hipSuccess || per_cu < 1) { fprintf(stderr, "occupancy query: %d\n", per_cu); per_cu = 1; }
        (void)hipGetLastError();
        grid = cus * 1;
    }
    if (grid < 0) return;
    if (hipMemsetAsync((char*)d_ws + WS_BAR, 0, 16384, stream) != hipSuccess) { fprintf(stderr, "memset failed\n"); return; }
    Args a{};
    for (int i = 0; i < 16; ++i) a.in[i] = (const float*)d_in[i];
    a.out = (float*)d_out; a.ws = (unsigned char*)d_ws;
    void* args[] = {&a};
    hipError_t e = hipLaunchCooperativeKernel((const void*)fwd_kernel, dim3(grid), dim3(512), args, LDS_BYTES, stream);
    if (e != hipSuccess) fprintf(stderr, "cooperative launch failed: %s (grid %d)\n", hipGetErrorString(e), grid);
}
```

```cpp
#include <hip/hip_runtime.h>
#include <hip/hip_cooperative_groups.h>
#include <cstdio>
#include <cstdint>
namespace cgx = cooperative_groups;
namespace pg8 {
#define PG8_LAS __attribute__((address_space(3)))
typedef unsigned short bf16_t;
typedef short bf16x8 __attribute__((ext_vector_type(8)));
typedef float f32x4 __attribute__((ext_vector_type(4)));
typedef unsigned u32x4 __attribute__((ext_vector_type(4)));
constexpr int BM = 256, BK = 64, HALF = 128, HTB = HALF * BK * 2  , STAGE_BYTES = 8 * HTB, NXCD = 8, WGM = 8;

__host__ __device__ __forceinline__ int lds_byte(int r, int c) { const int st = (r >> 4) * 2 + (c >> 5), rr = r & 15, cc = c & 31, ob = rr * 64 + cc * 2; return st * 1024 + (ob ^ (((ob >> 9) & 1) << 5)); }
__host__ __device__ __forceinline__ void stage_rc(int b, int& R, int& C) { const int st = b / 1024, sb = b % 1024, swz = sb ^ (((sb >> 9) & 1) << 5); R = (st >> 1) * 16 + swz / 64; C = (st & 1) * 32 + (swz % 64) / 2; }
__host__ __device__ __forceinline__ int perm32(int rho) { const int n = rho >> 4, i = rho & 15; return 8 * (i >> 2) + 4 * n + (i & 3); }

struct Unit { int pm, pn, w; };
struct Gemm { const bf16_t* A; const bf16_t* Bt; int M, N, K; const bf16_t* A2; const bf16_t* Bt2; };

struct StaticOrder {
    int nM, nN, nwg, G, c;
    __host__ __device__ void init(int M, int N, int G_, int c_) { nM = M / BM; nN = N / BM; nwg = nM * nN; G = G_; c = c_; }
    __host__ __device__ bool next(int i, Unit& u) const { return map((long)i * G + c, u); }
    __host__ __device__ bool map(long L, Unit& u) const {
        if (L >= nwg) return false; u.w = 0;
        int wgid = (int)L; { const int q = nwg / NXCD, r = nwg % NXCD, xcd = wgid % NXCD, off = wgid / NXCD; wgid = (xcd < r ? xcd * (q + 1) : r * (q + 1) + (xcd - r) * q) + off; }
        const int nig = WGM * nN, gid = wgid / nig, fm = gid * WGM, gsz = (nM - fm) < WGM ? (nM - fm) : WGM;
        u.pm = fm + ((wgid % nig) % gsz); u.pn = (wgid % nig) / gsz; return true;
    }
    __device__ __forceinline__ void a_ready(const Unit&) const {}
    __device__ __forceinline__ void done(const Unit&) const {}
};
struct DualOrder {
    StaticOrder s0, s1; int G, c;
    __host__ __device__ bool next(int i, Unit& u) const {
        long L = (long)i * G + c; const bool second = L >= s0.nwg; if (second) L -= s0.nwg;
        StaticOrder t; t.nM = second ? s1.nM : s0.nM; t.nN = second ? s1.nN : s0.nN; t.nwg = second ? s1.nwg : s0.nwg; t.G = G; t.c = c;
        const bool ok = t.map(L, u); u.w = second ? 1 : 0; return ok; }
    __device__ __forceinline__ void a_ready(const Unit&) const {}
    __device__ __forceinline__ void done(const Unit&) const {}
};

__device__ __forceinline__ unsigned cvt_pk_bf16(float lo, float hi) { unsigned r; asm volatile("v_cvt_pk_bf16_f32 %0, %1, %2" : "=v"(r) : "v"(lo), "v"(hi)); return r; }
typedef float f32x2 __attribute__((ext_vector_type(2)));
template <class Epi, class Sched, bool ALIGN_EPI = false, bool SP2 = false>
__device__ __forceinline__ void gemm_phase(PG8_LAS unsigned char* lds, const Gemm g, const Sched& S, const Epi& E) {
    int tid_l = threadIdx.x; asm volatile("" : "+v"(tid_l));
    const int tid = tid_l, wid = __builtin_amdgcn_readfirstlane(tid >> 6), lane = tid & 63, wr = wid >> 2, wc = wid & 3, fr = lane & 15, fq = lane >> 4;
    const int K = g.K, nt = K / BK;
    unsigned voffA[2], voffB[2];
#pragma unroll
    for (int i = 0; i < 2; ++i) { int R, C; stage_rc(tid * 16 + i * 8192, R, C); const int Rb = Epi::PERM ? ((R & ~31) + perm32(R & 31)) : R;
        voffA[i] = (unsigned)(R * K + C) * 2u; voffB[i] = (unsigned)(Rb * K + C) * 2u; }
    const size_t kstep = (size_t)(BK * 2);
    const size_t hstep = (size_t)HALF * K * 2;
    const size_t tstep = 2 * hstep;
    const unsigned ldsw = (unsigned)wid * 1024u;
    const int aoff = lds_byte(wr * 64 + fr, fq * 8), boff = lds_byte(wc * 32 + fr, fq * 8);
#define PG8_SA(b, h) (((b) * 2 + (h)) * HTB)
#define PG8_SB(b, h) ((4 + (b) * 2 + (h)) * HTB)
#define PG8_STAGE(bufoff, gbase, voff) do { _Pragma("unroll") for (int _i = 0; _i < 2; ++_i) \
        __builtin_amdgcn_global_load_lds((const unsigned*)((const char*)(gbase) + (voff)[_i]), (PG8_LAS unsigned*)(lds + (bufoff) + ldsw + _i * 8192), 16, 0, 0); } while (0)
#define PG8_LDA(dst, b, h) do { _Pragma("unroll") for (int m = 0; m < 4; ++m) _Pragma("unroll") for (int k = 0; k < 2; ++k) dst[m][k] = *(const PG8_LAS bf16x8*)(lds + PG8_SA(b, h) + aoff + m * 2048 + k * 1024); } while (0)
#define PG8_LDB(dst, b, h) do { _Pragma("unroll") for (int n = 0; n < 2; ++n) _Pragma("unroll") for (int k = 0; k < 2; ++k) dst[n][k] = *(const PG8_LAS bf16x8*)(lds + PG8_SB(b, h) + boff + n * 2048 + k * 1024); } while (0)
#define PG8_MMA(ai, bj, At, Bt) do { __builtin_amdgcn_s_setprio(1); _Pragma("unroll") for (int m = 0; m < 4; ++m) _Pragma("unroll") for (int n = 0; n < 2; ++n) _Pragma("unroll") for (int k = 0; k < 2; ++k) \
        acc[ai][bj][m][n] = __builtin_amdgcn_mfma_f32_16x16x32_bf16(Bt[n][k], At[m][k], acc[ai][bj][m][n], 0, 0, 0); __builtin_amdgcn_s_setprio(0); } while (0)
#define PG8_WAIT_V(n) asm volatile("s_waitcnt vmcnt(" #n ")" ::: "memory")
#define PG8_WAIT_L(n) asm volatile("s_waitcnt lgkmcnt(" #n ")" ::: "memory")
#define PG8_BAR __builtin_amdgcn_s_barrier()
#define PG8_SCHED __builtin_amdgcn_sched_barrier(0)
    Unit cur, nxt; int ui = 0;
    if (!S.next(0, cur)) return;
    f32x4 acc[2][2][4][2];
#pragma unroll
    for (int a = 0; a < 2; ++a)
#pragma unroll
        for (int b = 0; b < 2; ++b)
#pragma unroll
            for (int m = 0; m < 4; ++m)
#pragma unroll
                for (int n = 0; n < 2; ++n) acc[a][b][m][n] = (f32x4){0.f, 0.f, 0.f, 0.f};
    bf16x8 At[4][2], B0[2][2], B1[2][2];
    const char* const gA0 = (const char*)g.A; const char* const gA1 = (const char*)g.A2; const char* const gB0 = (const char*)g.Bt; const char* const gB1 = (const char*)g.Bt2;
    const char* cA = (cur.w != 0 ? gA1 : gA0) + (size_t)cur.pm * tstep; const char* cB = (cur.w != 0 ? gB1 : gB0) + (size_t)cur.pn * tstep;
    S.a_ready(cur);
    if constexpr (SP2) {
        PG8_STAGE(PG8_SB(0, 0), cB, voffB); PG8_STAGE(PG8_SB(0, 1), cB + hstep, voffB); PG8_STAGE(PG8_SA(0, 0), cA, voffA); PG8_STAGE(PG8_SA(0, 1), cA + hstep, voffA);
        if (wr == 1) PG8_BAR;
        PG8_WAIT_V(2); PG8_BAR;
        PG8_STAGE(PG8_SB(1, 0), cB + kstep, voffB); PG8_STAGE(PG8_SA(1, 0), cA + kstep, voffA); PG8_STAGE(PG8_SB(1, 1), cB + hstep + kstep, voffB);
        PG8_WAIT_V(6); PG8_BAR;
    } else {
        PG8_STAGE(PG8_SB(0, 0), cB, voffB); PG8_STAGE(PG8_SA(0, 0), cA, voffA); PG8_STAGE(PG8_SB(0, 1), cB + hstep, voffB); PG8_STAGE(PG8_SA(0, 1), cA + hstep, voffA);
        if (wr == 1) PG8_BAR;
        PG8_WAIT_V(4); PG8_BAR;
        PG8_STAGE(PG8_SB(1, 0), cB + kstep, voffB); PG8_STAGE(PG8_SA(1, 0), cA + kstep, voffA); PG8_STAGE(PG8_SB(1, 1), cB + hstep + kstep, voffB);
        PG8_WAIT_V(6); PG8_BAR;
    }
    for (;;) {
        const bool has_next = S.next(ui + 1, nxt);
        const char* nA = has_next ? (nxt.w != 0 ? gA1 : gA0) + (size_t)nxt.pm * tstep : cA; const char* nB = has_next ? (nxt.w != 0 ? gB1 : gB0) + (size_t)nxt.pn * tstep : cB;
        for (int t = 0; t < nt; t += 2) {
            const bool last = (t == nt - 2);
            const char* a1 = cA + (size_t)(t + 1) * kstep;
            const char* a2 = last ? nA : cA + (size_t)(t + 2) * kstep; const char* b2 = last ? nB : cB + (size_t)(t + 2) * kstep;
            const char* a3 = a2 + kstep; const char* b3 = b2 + kstep;
            if (last && has_next) S.a_ready(nxt);
            if constexpr (SP2) {
            PG8_LDB(B0, 0, 0); PG8_LDB(B1, 0, 1); PG8_SCHED; PG8_LDA(At, 0, 0); PG8_STAGE(PG8_SA(1, 1), a1 + hstep, voffA);
            PG8_WAIT_V(8); PG8_WAIT_L(0); PG8_BAR; PG8_MMA(0, 0, At, B0); PG8_MMA(0, 1, At, B1); PG8_BAR; PG8_SCHED;
            PG8_LDA(At, 0, 1); PG8_STAGE(PG8_SB(0, 0), b2, voffB); PG8_STAGE(PG8_SB(0, 1), b2 + hstep, voffB); PG8_STAGE(PG8_SA(0, 0), a2, voffA);
            PG8_WAIT_V(8); PG8_WAIT_L(0); PG8_BAR; PG8_MMA(1, 0, At, B0); PG8_MMA(1, 1, At, B1); PG8_BAR; PG8_SCHED;
            PG8_LDB(B0, 1, 0); PG8_LDB(B1, 1, 1); PG8_SCHED; PG8_LDA(At, 1, 0); PG8_STAGE(PG8_SA(0, 1), a2 + hstep, voffA);
            PG8_WAIT_V(8); PG8_WAIT_L(0); PG8_BAR; PG8_MMA(0, 0, At, B0); PG8_MMA(0, 1, At, B1); PG8_BAR; PG8_SCHED;
            PG8_LDA(At, 1, 1); PG8_STAGE(PG8_SB(1, 0), b3, voffB); PG8_STAGE(PG8_SB(1, 1), b3 + hstep, voffB); PG8_STAGE(PG8_SA(1, 0), a3, voffA);
            PG8_WAIT_V(8); PG8_WAIT_L(0); PG8_BAR; PG8_MMA(1, 0, At, B0); PG8_MMA(1, 1, At, B1); PG8_BAR; PG8_SCHED;
            } else {
            PG8_LDB(B0, 0, 0); PG8_SCHED; PG8_LDA(At, 0, 0); PG8_STAGE(PG8_SA(1, 1), a1 + hstep, voffA);
            PG8_WAIT_L(8); PG8_BAR; PG8_WAIT_L(0); PG8_MMA(0, 0, At, B0); PG8_BAR; PG8_SCHED;
            PG8_LDB(B1, 0, 1); PG8_STAGE(PG8_SB(0, 0), b2, voffB);
            PG8_BAR; PG8_WAIT_L(0); PG8_MMA(0, 1, At, B1); PG8_BAR;
            PG8_LDA(At, 0, 1); PG8_STAGE(PG8_SA(0, 0), a2, voffA);
            PG8_BAR; PG8_WAIT_L(0); PG8_MMA(1, 0, At, B0); PG8_BAR; PG8_SCHED;
            PG8_STAGE(PG8_SB(0, 1), b2 + hstep, voffB);
            PG8_WAIT_V(6); PG8_BAR; PG8_MMA(1, 1, At, B1); PG8_BAR;
            PG8_LDB(B0, 1, 0); PG8_SCHED; PG8_LDA(At, 1, 0); PG8_STAGE(PG8_SA(0, 1), a2 + hstep, voffA);
            PG8_WAIT_L(8); PG8_BAR; PG8_WAIT_L(0); PG8_MMA(0, 0, At, B0); PG8_BAR; PG8_SCHED;
            PG8_LDB(B1, 1, 1); PG8_STAGE(PG8_SB(1, 0), b3, voffB);
            PG8_BAR; PG8_WAIT_L(0); PG8_MMA(0, 1, At, B1); PG8_BAR;
            PG8_LDA(At, 1, 1); PG8_STAGE(PG8_SA(1, 0), a3, voffA);
            PG8_BAR; PG8_WAIT_L(0); PG8_MMA(1, 0, At, B0); PG8_BAR; PG8_SCHED;
            PG8_STAGE(PG8_SB(1, 1), b3 + hstep, voffB);
            PG8_WAIT_V(6); PG8_BAR; PG8_MMA(1, 1, At, B1); PG8_BAR;
            }
        }
        if constexpr (ALIGN_EPI) { if (wr == 0) PG8_BAR; }
        if constexpr (!Epi::AFTER_DRAIN) { E(acc, cur, wr, wc, fr, fq); S.done(cur); }
        if (!has_next) break;
#pragma unroll
        for (int a = 0; a < 2; ++a)
#pragma unroll
            for (int b = 0; b < 2; ++b)
#pragma unroll
                for (int m = 0; m < 4; ++m)
#pragma unroll
                    for (int n = 0; n < 2; ++n) acc[a][b][m][n] = (f32x4){0.f, 0.f, 0.f, 0.f};
        cur = nxt; cA = nA; cB = nB; ++ui;
        if constexpr (ALIGN_EPI) { if (wr == 1) PG8_BAR; }
    }
    PG8_WAIT_V(0);
    if constexpr (!ALIGN_EPI) { if (wr == 0) PG8_BAR; }
    PG8_BAR;
    if constexpr (Epi::AFTER_DRAIN) { E.fused(acc, cur, wr, wc, fr, fq, lds, wid, lane); S.done(cur); }
#undef PG8_SA
#undef PG8_SB
#undef PG8_STAGE
#undef PG8_LDA
#undef PG8_LDB
#undef PG8_MMA
#undef PG8_WAIT_V
#undef PG8_WAIT_L
#undef PG8_BAR
#undef PG8_SCHED
}
}
#define LAS __attribute__((address_space(3)))
typedef unsigned short bf16_t;
typedef short bf16x8 __attribute__((ext_vector_type(8)));
typedef float f32x4 __attribute__((ext_vector_type(4)));
typedef float f32x16 __attribute__((ext_vector_type(16)));
typedef unsigned u32x4 __attribute__((ext_vector_type(4)));
typedef unsigned u32x2 __attribute__((ext_vector_type(2)));
constexpr int DM = 1024, SEQL = 4096, NSEQ = 12, MTOT = NSEQ * SEQL, CH_SEQ = 4, MC = CH_SEQ * SEQL, NCHUNK = NSEQ / CH_SEQ, DEPTH = 4;
constexpr int NPROJ = 10240, NIN = 9216;
constexpr float EPS = 1e-6f, LOG2E = 1.4426950408889634f;
constexpr size_t MiB = 1u << 20;
constexpr size_t WS_MISC = 0, WS_PART = 1 * MiB, WS_WIN = 4 * MiB, WS_WV = 76 * MiB, WS_WA = 84 * MiB, WS_WB = 92 * MiB, WS_WO = 100 * MiB, WS_XB = 108 * MiB,
                 WS_Q = 204 * MiB, WS_K = 236 * MiB, WS_VT = 268 * MiB, WS_GA = 300 * MiB, WS_U = 332 * MiB, WS_W = 364 * MiB, WS_MA = 396 * MiB, WS_MB = 428 * MiB, WS_BC = 460 * MiB, WS_END = 492 * MiB;
constexpr int TABN = 640, TABZ = 320;
constexpr int LDS_BYTES = 147456;

__device__ __forceinline__ float bf2f(unsigned short b) { return __uint_as_float(((unsigned)b) << 16); }
__device__ __forceinline__ float bflo(unsigned w) { return __uint_as_float(w << 16); }
__device__ __forceinline__ float bfhi(unsigned w) { return __uint_as_float(w & 0xffff0000u); }
__device__ __forceinline__ unsigned pkbf(float lo, float hi) { return pg8::cvt_pk_bf16(lo, hi); }
__device__ __forceinline__ float fast_rcp(float x) { return __builtin_amdgcn_rcpf(x); }
__device__ __forceinline__ float sigmoidf_(float x) { return fast_rcp(1.f + __builtin_amdgcn_exp2f(-x * LOG2E)); }
__device__ __forceinline__ float siluf_(float x) { return x * sigmoidf_(x); }
__device__ __forceinline__ f32x4 ld4(const float* p) { return *(const f32x4*)p; }

__device__ __forceinline__ float row_rstd(const float* part, int row) {
    const f32x4 a = ld4(part + (size_t)row * 16), b = ld4(part + (size_t)row * 16 + 4), c = ld4(part + (size_t)row * 16 + 8), d = ld4(part + (size_t)row * 16 + 12);
    const f32x4 s = (a + b) + (c + d);
    return __builtin_amdgcn_rsqf(((s[0] + s[1]) + (s[2] + s[3])) * (1.0f / DM) + EPS);
}
struct EpiInProj {
    static constexpr bool PERM = true, AFTER_DRAIN = false;
    const float* part; unsigned char* wsb; const float *gq, *gk, *cw;
    __device__ __forceinline__ void operator()(const f32x4 (&acc)[2][2][4][2], const pg8::Unit& u, int wr, int wc, int fr, int fq) const {
        const int pn = u.pn, rowb = u.pm * 256 + wr * 64 + fr;
        if (pn < 8) {
            const bool isq = pn < 4; const float* g = isq ? gq : gk; const float cs = isq ? 0.125f * LOG2E : 1.f; bf16_t* O = (bf16_t*)(wsb + (isq ? WS_Q : WS_K));
            const int cb = (pn & 3) * 256 + 64 * wc + 8 * fq;
            f32x4 gv[2][2];
#pragma unroll
            for (int bj = 0; bj < 2; ++bj)
#pragma unroll
                for (int n = 0; n < 2; ++n) gv[bj][n] = ld4(g + 32 * bj + 8 * fq + 4 * n) * cs;
#pragma unroll
            for (int ai = 0; ai < 2; ++ai)
#pragma unroll
                for (int m = 0; m < 4; ++m) {
                    const float rsv = row_rstd(part, rowb + ai * 128 + m * 16); float ss = 0.f;
#pragma unroll
                    for (int bj = 0; bj < 2; ++bj)
#pragma unroll
                        for (int n = 0; n < 2; ++n) { const f32x4 q = acc[ai][bj][m][n] * acc[ai][bj][m][n]; ss += (q[0] + q[1]) + (q[2] + q[3]); }
                    ss += __shfl_xor(ss, 16); ss += __shfl_xor(ss, 32);
                    const float r = __builtin_amdgcn_rsqf(ss * rsv * rsv * (1.0f / 64.0f) + EPS) * rsv;
                    bf16_t* rowp = O + (size_t)(rowb + ai * 128 + m * 16) * DM + cb;
#pragma unroll
                    for (int bj = 0; bj < 2; ++bj) { const f32x4 a = acc[ai][bj][m][0] * r * gv[bj][0], b = acc[ai][bj][m][1] * r * gv[bj][1];
                        u32x4 w; w.x = pkbf(a[0], a[1]); w.y = pkbf(a[2], a[3]); w.z = pkbf(b[0], b[1]); w.w = pkbf(b[2], b[3]); *(u32x4*)(rowp + 32 * bj) = w; }
                }
        } else if (pn >= 12 && pn < 28) {
            const int ch0 = 64 * (pn - 12) + 16 * wc + 4 * fq;
            const f32x4 c0 = ld4(cw + ch0), c1 = ld4(cw + DM + ch0), c2 = ld4(cw + 2 * DM + ch0);
            bf16_t* Up = (bf16_t*)(wsb + WS_U); bf16_t* Wp = (bf16_t*)(wsb + WS_W); bf16_t* Bp = (bf16_t*)(wsb + WS_BC);
#pragma unroll
            for (int ai = 0; ai < 2; ++ai) {
                f32x4 uu[4], ww[4], up[4], un[4];
#pragma unroll
                for (int m = 0; m < 4; ++m) {
                    const float r = row_rstd(part, rowb + ai * 128 + m * 16); const f32x4 xc = acc[ai][0][m][0] * r, cg = acc[ai][0][m][1] * r, bg = acc[ai][1][m][0] * r, gb = acc[ai][1][m][1] * r;
                    uu[m] = cg * xc;
#pragma unroll
                    for (int e = 0; e < 4; ++e) { ww[m][e] = bg[e] * siluf_(gb[e]);
                        up[m][e] = __int_as_float(__builtin_amdgcn_mov_dpp(__float_as_int(uu[m][e]), 0x121, 0xf, 0xf, false));
                        un[m][e] = __int_as_float(__builtin_amdgcn_mov_dpp(__float_as_int(uu[m][e]), 0x12f, 0xf, 0xf, false)); }
                }
#pragma unroll
                for (int m = 0; m < 4; ++m) {
                    const f32x4 z = {0.f, 0.f, 0.f, 0.f};
                    const f32x4 pv = (fr == 0) ? (m > 0 ? up[m > 0 ? m - 1 : 0] : z) : up[m], nv = (fr == 15) ? (m < 3 ? un[m < 3 ? m + 1 : 3] : z) : un[m];
                    const f32x4 bc = ww[m] * (c0 * pv + c1 * uu[m] + c2 * nv);
                    const size_t off = (size_t)(rowb + ai * 128 + m * 16) * DM + ch0;
                    const bool bnd = (m == 0 && fr == 0) || (m == 3 && fr == 15);
                    if (!bnd) { u32x2 o; o.x = pkbf(bc[0], bc[1]); o.y = pkbf(bc[2], bc[3]); *(u32x2*)(Bp + off) = o; }
                    if ((m == 0 && fr <= 1) || (m == 3 && fr >= 14)) {
                        u32x2 a; a.x = pkbf(uu[m][0], uu[m][1]); a.y = pkbf(uu[m][2], uu[m][3]); *(u32x2*)(Up + off) = a;
                        u32x2 b; b.x = pkbf(ww[m][0], ww[m][1]); b.y = pkbf(ww[m][2], ww[m][3]); *(u32x2*)(Wp + off) = b; }
                }
            }
        } else {
            const bool isga = pn < 12; bf16_t* O = (bf16_t*)(wsb + (isga ? WS_GA : (pn < 32 ? WS_MA : WS_MB))); const int t = isga ? pn - 8 : ((pn - 28) & 3);
            const int cb = t * 256 + 64 * wc + 8 * fq;
#pragma unroll
            for (int ai = 0; ai < 2; ++ai)
#pragma unroll
                for (int m = 0; m < 4; ++m) {
                    bf16_t* rowp = O + (size_t)(rowb + ai * 128 + m * 16) * DM + cb; const float rsv = row_rstd(part, rowb + ai * 128 + m * 16);
#pragma unroll
                    for (int bj = 0; bj < 2; ++bj) { f32x4 a = acc[ai][bj][m][0] * rsv, b = acc[ai][bj][m][1] * rsv;
#pragma unroll
                        for (int e = 0; e < 4; ++e) { const float sa = sigmoidf_(a[e]), sb = sigmoidf_(b[e]); a[e] = isga ? a[e] * sa : sa; b[e] = isga ? b[e] * sb : sb; }
                        u32x4 w; w.x = pkbf(a[0], a[1]); w.y = pkbf(a[2], a[3]); w.z = pkbf(b[0], b[1]); w.w = pkbf(b[2], b[3]); *(u32x4*)(rowp + 32 * bj) = w; }
                }
        }
    }
};
struct EpiVT {
    static constexpr bool PERM = true, AFTER_DRAIN = false;
    const float* part; unsigned char* wsb;
    __device__ __forceinline__ void operator()(const f32x4 (&acc)[2][2][4][2], const pg8::Unit& u, int wr, int wc, int fr, int fq) const {
        const int cb = u.pn * 256 + 32 * wc + 8 * fq, rowb = u.pm * 256 + wr * 64 + fr;
        f32x4 rs[2][2];
#pragma unroll
        for (int bj = 0; bj < 2; ++bj)
#pragma unroll
            for (int n = 0; n < 2; ++n)
#pragma unroll
                for (int e = 0; e < 4; ++e) rs[bj][n][e] = row_rstd(part, cb + 128 * bj + 4 * n + e);
#pragma unroll
        for (int ai = 0; ai < 2; ++ai)
#pragma unroll
            for (int m = 0; m < 4; ++m) { bf16_t* rowp = (bf16_t*)(wsb + WS_VT) + (size_t)(rowb + ai * 128 + m * 16) * MC + cb;
#pragma unroll
                for (int bj = 0; bj < 2; ++bj) { const f32x4 a = acc[ai][bj][m][0] * rs[bj][0], b = acc[ai][bj][m][1] * rs[bj][1];
                    u32x4 w; w.x = pkbf(a[0], a[1]); w.y = pkbf(a[2], a[3]); w.z = pkbf(b[0], b[1]); w.w = pkbf(b[2], b[3]); *(u32x4*)(rowp + 128 * bj) = w; } }
    }
};
template <int MODE> struct EpiGate {
    static constexpr bool PERM = true, AFTER_DRAIN = false;
    unsigned char* wsb;
    __device__ __forceinline__ void operator()(const f32x4 (&acc)[2][2][4][2], const pg8::Unit& u, int wr, int wc, int fr, int fq) const {
        const int cb = u.pn * 256 + 32 * wc + 8 * fq, rowb = u.pm * 256 + wr * 64 + fr;
        const bf16_t* G = (const bf16_t*)(wsb + (MODE ? WS_MB : WS_MA)); const bf16_t* Tin = (const bf16_t*)(wsb + WS_U); bf16_t* O = (bf16_t*)(wsb + (MODE ? WS_W : WS_U));
#pragma unroll
        for (int ai = 0; ai < 2; ++ai)
#pragma unroll
            for (int m = 0; m < 4; ++m) { const size_t off = (size_t)(rowb + ai * 128 + m * 16) * DM + cb;
#pragma unroll
                for (int bj = 0; bj < 2; ++bj) { const u32x4 g = *(const u32x4*)(G + off + 128 * bj); const f32x4 a = acc[ai][bj][m][0], b = acc[ai][bj][m][1];
                    float r[8] = {a[0] * bflo(g.x), a[1] * bfhi(g.x), a[2] * bflo(g.y), a[3] * bfhi(g.y), b[0] * bflo(g.z), b[1] * bfhi(g.z), b[2] * bflo(g.w), b[3] * bfhi(g.w)};
                    if (MODE == 1) { const u32x4 t = *(const u32x4*)(Tin + off + 128 * bj);
                        r[0] += bflo(t.x); r[1] += bfhi(t.x); r[2] += bflo(t.y); r[3] += bfhi(t.y); r[4] += bflo(t.z); r[5] += bfhi(t.z); r[6] += bflo(t.w); r[7] += bfhi(t.w); }
                    u32x4 w; w.x = pkbf(r[0], r[1]); w.y = pkbf(r[2], r[3]); w.z = pkbf(r[4], r[5]); w.w = pkbf(r[6], r[7]); *(u32x4*)(O + off + 128 * bj) = w; } }
    }
};
struct EpiOut {
    static constexpr bool PERM = true, AFTER_DRAIN = false;
    const float* xin; float* xout; bf16_t* XB; float* part; int first, last;
    __device__ __forceinline__ void operator()(const f32x4 (&acc)[2][2][4][2], const pg8::Unit& u, int wr, int wc, int fr, int fq) const {
        const int cb = u.pn * 256 + 32 * wc + 8 * fq, rowb = u.pm * 256 + wr * 64 + fr;
#pragma unroll
        for (int ai = 0; ai < 2; ++ai)
#pragma unroll
            for (int m = 0; m < 4; ++m) { const int row = rowb + ai * 128 + m * 16; const size_t off = (size_t)row * DM + cb; float ss = 0.f;
#pragma unroll
                for (int bj = 0; bj < 2; ++bj) { f32x4 a = acc[ai][bj][m][0], b = acc[ai][bj][m][1];
                    if (first) { a = a + ld4(xin + off + 128 * bj); b = b + ld4(xin + off + 128 * bj + 4); }
                    else { const u32x4 xb = *(const u32x4*)(XB + off + 128 * bj);
                        a = a + (f32x4){bflo(xb.x), bfhi(xb.x), bflo(xb.y), bfhi(xb.y)}; b = b + (f32x4){bflo(xb.z), bfhi(xb.z), bflo(xb.w), bfhi(xb.w)}; }
                    if (last) { *(f32x4*)(xout + off + 128 * bj) = a; *(f32x4*)(xout + off + 128 * bj + 4) = b; }
                    else { u32x4 w; w.x = pkbf(a[0], a[1]); w.y = pkbf(a[2], a[3]); w.z = pkbf(b[0], b[1]); w.w = pkbf(b[2], b[3]); *(u32x4*)(XB + off + 128 * bj) = w;
                        const f32x4 qa = a * a, qb = b * b; ss += ((qa[0] + qa[1]) + (qa[2] + qa[3])) + ((qb[0] + qb[1]) + (qb[2] + qb[3])); } }
                if (!last) { ss += __shfl_xor(ss, 16); ss += __shfl_xor(ss, 32);
                    if (fq == 0) part[(size_t)row * 16 + u.pn * 4 + wc] = ss; } }
    }
};

template <class E0, class E1> struct EpiDual {
    static constexpr bool PERM = true, AFTER_DRAIN = false;
    E0 e0; E1 e1;
    __device__ __forceinline__ void operator()(const f32x4 (&acc)[2][2][4][2], const pg8::Unit& u, int wr, int wc, int fr, int fq) const { if (u.w) e1(acc, u, wr, wc, fr, fq); else e0(acc, u, wr, wc, fr, fq); }
};
namespace att {
constexpr int KP = 256, VP = 128, KBY = 64 * KP, VBY = 128 * VP;
constexpr int OFF_TAB = 69632, OFF_L = OFF_TAB + 2560, XP = 132;
__device__ __forceinline__ int crow(int r, int hi) { return (r & 3) + 8 * (r >> 2) + 4 * hi; }
__device__ __forceinline__ bf16x8 pack8(const f32x16& p, int b) {
    u32x4 w; w.x = pkbf(p[b], p[b + 1]); w.y = pkbf(p[b + 2], p[b + 3]); w.z = pkbf(p[b + 4], p[b + 5]); w.w = pkbf(p[b + 6], p[b + 7]); return __builtin_bit_cast(bf16x8, w); }
__device__ __forceinline__ void attn_unit(LAS unsigned char* lds, const bf16_t* Q, const bf16_t* K, const bf16_t* VT, const bf16_t* GA, bf16_t* O, const float* tabg,
                                          float lam, const float* subg, float osc, int seq, int h, int qb, int rot) {
    int tid_l = threadIdx.x; asm volatile("" : "+v"(tid_l));
    const int tid = tid_l, lane = tid & 63, r32 = lane & 31, hi = lane >> 5, wid = __builtin_amdgcn_readfirstlane(tid >> 6), sm = wid >> 2, qg = wid & 3;
    const int tok0 = seq * SEQL, q0 = qb * 128;
    LAS float* tabl = (LAS float*)(lds + OFF_TAB);
    for (int i = tid; i < TABN; i += 512) tabl[i] = tabg[i];
    const float b_lo = tabg[0], b_hi = tabg[TABN - 1];
    bf16x8 qf[4];
    { const bf16_t* qp = Q + (size_t)(tok0 + q0 + qg * 32 + r32) * DM + h * 128 + sm * 64 + hi * 8;
#pragma unroll
      for (int d0 = 0; d0 < 4; ++d0) qf[d0] = *(const bf16x8*)(qp + d0 * 16); }
    const bf16_t* kg[2]; const bf16_t* vg[2];
#pragma unroll
    for (int i = 0; i < 2; ++i) { const int pc = 2 * wid + i;
        { const int row = 4 * pc + (lane >> 4), c = (lane & 15) ^ (row & 15); kg[i] = K + (size_t)(tok0 + row) * DM + h * 128 + c * 8; }
        { const int row = 8 * pc + (lane >> 3), c = (lane & 7) ^ ((row >> 1) & 7); vg[i] = VT + (size_t)(h * 128 + row) * MC + tok0 + c * 8; } }
#define ATT_DMA_K(tile, kbo) do { _Pragma("unroll") for (int i = 0; i < 2; ++i) \
        __builtin_amdgcn_global_load_lds((const unsigned*)(kg[i] + (size_t)(tile) * 64 * DM), (LAS unsigned*)(lds + (kbo) + (2 * wid + i) * 1024), 16, 0, 0); } while (0)
#define ATT_DMA_V(tile, vbo) do { _Pragma("unroll") for (int i = 0; i < 2; ++i) \
        __builtin_amdgcn_global_load_lds((const unsigned*)(vg[i] + (tile) * 64), (LAS unsigned*)(lds + 2 * KBY + (vbo) + (2 * wid + i) * 1024), 16, 0, 0); } while (0)
    ATT_DMA_K(rot, 0); ATT_DMA_V(rot, 0); ATT_DMA_K((rot + 1) & 63, KBY);
    asm volatile("s_waitcnt vmcnt(0)" ::: "memory");
    __syncthreads();
    f32x16 o[4];
#pragma unroll
    for (int d0 = 0; d0 < 4; ++d0)
#pragma unroll
        for (int r = 0; r < 16; ++r) o[d0][r] = 0.f;
    float l = 0.f; int cc = 1;
    const int kact = (r32 & 19) | ((r32 & 4) << 1) | ((r32 & 8) >> 1);
    int kofs[4], vofs[4];
#pragma unroll
    for (int d0 = 0; d0 < 4; ++d0) { kofs[d0] = kact * KP + (((sm * 8 + 2 * d0 + hi) ^ (kact & 15)) << 4); vofs[d0] = 2 * KBY + r32 * VP + (((2 * d0 + hi) ^ ((r32 >> 1) & 7)) << 4); }
    const int qpos = q0 + qg * 32 + r32;
#define ATT_CLASS(k0) (((k0) + 63 <= q0 + qg * 32 - 91) ? 0 : (((k0) >= q0 + qg * 32 + 31 + 91) ? 2 : 1))
#define ATT_EV(c) ((c) == 0 ? b_lo : ((c) == 2 ? b_hi : 0.f))
#define ATT_SBAR() __builtin_amdgcn_sched_barrier(0)
#define ATT_EXP4(P, b) do { P[(b)] = __builtin_amdgcn_exp2f(P[(b)]); P[(b) + 1] = __builtin_amdgcn_exp2f(P[(b) + 1]); P[(b) + 2] = __builtin_amdgcn_exp2f(P[(b) + 2]); P[(b) + 3] = __builtin_amdgcn_exp2f(P[(b) + 3]); } while (0)
#define ATT_S01(N0, N1, k0, a0_, a1_) do { \
        if (ATT_CLASS(k0) == 1) { \
            const LAS float* tb_ = tabl + ((k0) + 8 * hi - qpos + TABZ);     \
            _Pragma("unroll") for (int r = 0; r < 16; ++r) { N0[r] = tb_[16 * (r >> 3) + (r & 7)]; N1[r] = tb_[16 * (r >> 3) + (r & 7) + 32]; } \
            N0 = __builtin_amdgcn_mfma_f32_32x32x16_bf16(a0_, qf[0], N0, 0, 0, 0); N1 = __builtin_amdgcn_mfma_f32_32x32x16_bf16(a1_, qf[0], N1, 0, 0, 0); \
        } else { const f32x16 z_ = {0.f, 0.f, 0.f, 0.f, 0.f, 0.f, 0.f, 0.f, 0.f, 0.f, 0.f, 0.f, 0.f, 0.f, 0.f, 0.f}; \
            N0 = __builtin_amdgcn_mfma_f32_32x32x16_bf16(a0_, qf[0], z_, 0, 0, 0); N1 = __builtin_amdgcn_mfma_f32_32x32x16_bf16(a1_, qf[0], z_, 0, 0, 0); } } while (0)
#define ATT_STEP(C0, C1, N0, N1, T) do { \
        const int t_ = (T), k0_ = ((t_ + rot) & 63) * 64, k1_ = ((t_ + 1 + rot) & 63) * 64; \
        { const int cn_ = ATT_CLASS(k0_); if (cn_ != cc) { const float sc = __builtin_amdgcn_exp2f(ATT_EV(cc) - ATT_EV(cn_)); \
            _Pragma("unroll") for (int d0 = 0; d0 < 4; ++d0) o[d0] = o[d0] * sc; \
            l *= sc; cc = cn_; } } \
        const LAS unsigned char* kb = lds + ((t_ + 1) & 1) * KBY; \
        { bf16x8 ka0_ = *(const LAS bf16x8*)(kb + kofs[0]), ka1_ = *(const LAS bf16x8*)(kb + kofs[0] + 32 * KP); bf16x8 ka[6]; \
          _Pragma("unroll") for (int d0 = 1; d0 < 4; ++d0) { ka[2 * d0 - 2] = *(const LAS bf16x8*)(kb + kofs[d0]); ka[2 * d0 - 1] = *(const LAS bf16x8*)(kb + kofs[d0] + 32 * KP); } \
          ATT_EXP4(C0, 0); ATT_EXP4(C1, 0); \
          ATT_SBAR(); \
          ATT_S01(N0, N1, k1_, ka0_, ka1_); \
          ATT_SBAR(); \
          _Pragma("unroll") for (int d0 = 1; d0 < 4; ++d0) { \
              N0 = __builtin_amdgcn_mfma_f32_32x32x16_bf16(ka[2 * d0 - 2], qf[d0], N0, 0, 0, 0); ATT_EXP4(C0, 4 * d0); \
              N1 = __builtin_amdgcn_mfma_f32_32x32x16_bf16(ka[2 * d0 - 1], qf[d0], N1, 0, 0, 0); ATT_EXP4(C1, 4 * d0); } \
          _Pragma("unroll") for (int g_ = 0; g_ < 6; ++g_) { __builtin_amdgcn_sched_group_barrier(0x008, 1, 0); __builtin_amdgcn_sched_group_barrier(0x400, 4, 0); } } \
        ATT_SBAR(); \
        ATT_DMA_K((t_ + 2 + rot) & 63, (t_ & 1) * KBY); ATT_DMA_V((t_ + 1 + rot) & 63, ((t_ + 1) & 1) * VBY);     \
        { bf16x8 pa[4]; pa[0] = pack8(C0, 0); pa[1] = pack8(C0, 8); pa[2] = pack8(C1, 0); pa[3] = pack8(C1, 8); \
          { float s_[4]; \
            _Pragma("unroll") for (int r = 0; r < 4; ++r) s_[r] = C0[r] + C1[r]; \
            _Pragma("unroll") for (int r = 4; r < 16; ++r) s_[r & 3] += C0[r] + C1[r]; \
            l += (s_[0] + s_[1]) + (s_[2] + s_[3]); } \
          ATT_SBAR(); \
          const LAS unsigned char* vb = lds + (t_ & 1) * VBY; \
          bf16x8 v0[4], v1[4]; \
          _Pragma("unroll") for (int d0 = 0; d0 < 4; ++d0) v0[d0] = *(const LAS bf16x8*)(vb + vofs[0] + d0 * 32 * VP); \
          _Pragma("unroll") for (int d0 = 0; d0 < 4; ++d0) v1[d0] = *(const LAS bf16x8*)(vb + vofs[1] + d0 * 32 * VP); \
          _Pragma("unroll") for (int d0 = 0; d0 < 4; ++d0) o[d0] = __builtin_amdgcn_mfma_f32_32x32x16_bf16(pa[0], v0[d0], o[d0], 0, 0, 0); \
          _Pragma("unroll") for (int d0 = 0; d0 < 4; ++d0) v0[d0] = *(const LAS bf16x8*)(vb + vofs[2] + d0 * 32 * VP); \
          _Pragma("unroll") for (int d0 = 0; d0 < 4; ++d0) o[d0] = __builtin_amdgcn_mfma_f32_32x32x16_bf16(pa[1], v1[d0], o[d0], 0, 0, 0); \
          _Pragma("unroll") for (int d0 = 0; d0 < 4; ++d0) v1[d0] = *(const LAS bf16x8*)(vb + vofs[3] + d0 * 32 * VP); \
          _Pragma("unroll") for (int d0 = 0; d0 < 4; ++d0) o[d0] = __builtin_amdgcn_mfma_f32_32x32x16_bf16(pa[2], v0[d0], o[d0], 0, 0, 0); \
          _Pragma("unroll") for (int d0 = 0; d0 < 4; ++d0) o[d0] = __builtin_amdgcn_mfma_f32_32x32x16_bf16(pa[3], v1[d0], o[d0], 0, 0, 0); \
          __builtin_amdgcn_sched_group_barrier(0x100, 8, 0); \
          _Pragma("unroll") for (int j = 0; j < 8; ++j) { __builtin_amdgcn_sched_group_barrier(0x008, 1, 0); __builtin_amdgcn_sched_group_barrier(0x100, 1, 0); } \
          __builtin_amdgcn_sched_group_barrier(0x008, 8, 0); } \
        ATT_SBAR(); \
        asm volatile("s_waitcnt vmcnt(0)" ::: "memory"); \
        __syncthreads(); \
    } while (0)
    f32x16 pA0, pA1, pB0, pB1;
    {
        const LAS unsigned char* kb = lds; const int k00 = rot * 64;
        const bf16x8 b0_ = *(const LAS bf16x8*)(kb + kofs[0]), b1_ = *(const LAS bf16x8*)(kb + kofs[0] + 32 * KP);
        ATT_S01(pA0, pA1, k00, b0_, b1_);
#pragma unroll
        for (int d0 = 1; d0 < 4; ++d0) { const bf16x8 a0 = *(const LAS bf16x8*)(kb + kofs[d0]), a1 = *(const LAS bf16x8*)(kb + kofs[d0] + 32 * KP);
            pA0 = __builtin_amdgcn_mfma_f32_32x32x16_bf16(a0, qf[d0], pA0, 0, 0, 0); pA1 = __builtin_amdgcn_mfma_f32_32x32x16_bf16(a1, qf[d0], pA1, 0, 0, 0); }
    }
    __syncthreads();
    for (int t = 0; t < 64; t += 2) {
        ATT_STEP(pA0, pA1, pB0, pB1, t);
        ATT_STEP(pB0, pB1, pA0, pA1, t + 1);
    }
#undef ATT_STEP
#undef ATT_DMA_K
#undef ATT_DMA_V
#undef ATT_S01
#undef ATT_EXP4
#undef ATT_SBAR
#undef ATT_CLASS
#undef ATT_EV
    l += __shfl_xor(l, 32);
    LAS float* Ls = (LAS float*)(lds + OFF_L) + wid * 32;
    if (hi == 0) Ls[r32] = l;
    asm volatile("s_waitcnt lgkmcnt(0)" ::: "memory");
    float inv[16];
#pragma unroll
    for (int r = 0; r < 16; ++r) inv[r] = (sm ? lam : 1.f) * fast_rcp(Ls[crow(r, hi)]);
    LAS float* X = (LAS float*)lds + qg * (32 * XP);
    if (sm == 1) {
#pragma unroll
        for (int d0 = 0; d0 < 4; ++d0)
#pragma unroll
            for (int r = 0; r < 16; ++r) X[crow(r, hi) * XP + d0 * 32 + r32] = o[d0][r] * inv[r];
    }
    __syncthreads();
    if (sm == 0) {
#pragma unroll
        for (int d0 = 0; d0 < 4; ++d0)
#pragma unroll
            for (int r = 0; r < 16; ++r) { const int ix = crow(r, hi) * XP + d0 * 32 + r32; X[ix] = o[d0][r] * inv[r] - X[ix]; }
        asm volatile("s_waitcnt lgkmcnt(0)" ::: "memory");
        const LAS float* xr = X + r32 * XP + hi * 64;
        f32x4 xv[16]; float ss = 0.f;
#pragma unroll
        for (int j = 0; j < 16; ++j) { xv[j] = *(const LAS f32x4*)(xr + 4 * j); const f32x4 q = xv[j] * xv[j]; ss += (q[0] + q[1]) + (q[2] + q[3]); }
        ss += __shfl_xor(ss, 32);
        const float rstd = __builtin_amdgcn_rsqf(ss * (1.0f / 128.0f) + EPS) * osc;
        const size_t off = (size_t)(tok0 + q0 + qg * 32 + r32) * DM + h * 128 + hi * 64;
#pragma unroll
        for (int j = 0; j < 8; ++j) { const u32x4 g = *(const u32x4*)(GA + off + 8 * j); const f32x4 s0 = ld4(subg + hi * 64 + 8 * j), s1 = ld4(subg + hi * 64 + 8 * j + 4);
            const f32x4 a = xv[2 * j] * rstd * s0, b = xv[2 * j + 1] * rstd * s1;
            u32x4 w; w.x = pkbf(a[0] * bflo(g.x), a[1] * bfhi(g.x)); w.y = pkbf(a[2] * bflo(g.y), a[3] * bfhi(g.y)); w.z = pkbf(b[0] * bflo(g.z), b[1] * bfhi(g.z)); w.w = pkbf(b[2] * bflo(g.w), b[3] * bfhi(g.w));
            *(u32x4*)(O + off + 8 * j) = w; }
    }
    __syncthreads();
}
}
__device__ __forceinline__ unsigned f2bf(float f) { unsigned u = __builtin_bit_cast(unsigned, f); return (u + 0x7fffu + ((u >> 16) & 1u)) >> 16; }
__device__ __forceinline__ unsigned pk2(float lo, float hi) { return f2bf(lo) | (f2bf(hi) << 16); }
__device__ __forceinline__ int win_srccol(int gr) {
    const int pn = gr >> 8, gc = gr & 255, bj = gc >> 7, wc = (gc >> 5) & 3, j = gc & 31, lc = 64 * wc + 32 * bj + j;
    if (pn < 4) return 256 * pn + lc;
    if (pn < 8) return 1024 + 256 * (pn - 4) + lc;
    if (pn < 12) return 3072 + 256 * (pn - 8) + lc;
    if (pn < 28) { const int fq = (j >> 3) & 3, n = (j >> 2) & 1, e = j & 3; return 4096 + (2 * bj + n) * 1024 + 64 * (pn - 12) + 16 * wc + 4 * fq + e; }
    if (pn < 32) return 8192 + 256 * (pn - 28) + lc;
    return 9216 + 256 * (pn - 32) + lc;
}
__device__ __forceinline__ void tr_item(const float* W, int ldw, const float* gf, bf16_t* WT, int kind, int coff, int n0, int k0, LAS float* scr, int lane) {
    const int n4 = lane & 7, kr = lane >> 3, src = kind ? win_srccol(n0 + 4 * n4) : coff + n0 + 4 * n4;
#pragma unroll
    for (int i = 0; i < 8; ++i) { const int kk = 8 * i + kr; f32x4 v = ld4(W + (size_t)(k0 + kk) * ldw + src); if (gf) v = v * gf[k0 + kk];
        scr[kk * 33 + 4 * n4] = v[0]; scr[kk * 33 + 4 * n4 + 1] = v[1]; scr[kk * 33 + 4 * n4 + 2] = v[2]; scr[kk * 33 + 4 * n4 + 3] = v[3]; }
    asm volatile("s_waitcnt lgkmcnt(0)" ::: "memory");
    const int c = lane & 7;
#pragma unroll
    for (int j = 0; j < 4; ++j) { const int n = (lane >> 3) + 8 * j; const LAS float* s = scr + (8 * c) * 33 + n;
        u32x4 o; o.x = pk2(s[0 * 33], s[1 * 33]); o.y = pk2(s[2 * 33], s[3 * 33]); o.z = pk2(s[4 * 33], s[5 * 33]); o.w = pk2(s[6 * 33], s[7 * 33]);
        *(u32x4*)(WT + (size_t)(n0 + n) * DM + k0 + 8 * c) = o; }
    asm volatile("s_waitcnt lgkmcnt(0)" ::: "memory");
}
__device__ __forceinline__ float wave_sum(float v) {
#pragma unroll
    for (int o = 1; o < 64; o <<= 1) v += __shfl_xor(v, o);
    return v;
}
__device__ __forceinline__ int rel_bucket(int rel) {
    const int n = rel < 0 ? -rel : rel; int b;
    if (n < 8) b = n; else if (n < 12) b = 8; else if (n < 16) b = 9; else if (n < 23) b = 10; else if (n < 32) b = 11; else if (n < 46) b = 12; else if (n < 64) b = 13; else if (n < 91) b = 14; else b = 15;
    return (rel > 0 ? 16 : 0) + b;
}

#define XB_TMO      128
#define XB_XCNT(j)  (256  + 64 * (j))
#define XB_XSUB(j)  (1280 + 64 * (j))
#define XB_XGEN(j)  (2304 + 64 * (j))
#define XB_TOP      3328
#define XB_TOPGEN   3392
#define XCD_BAR_WORDS 3456
#define XB_SPIN_CAP (1u << 18)

__device__ __forceinline__ unsigned xb_ld(unsigned* p)              { return __hip_atomic_load(p, __ATOMIC_RELAXED, __HIP_MEMORY_SCOPE_AGENT); }
__device__ __forceinline__ unsigned xb_add(unsigned* p, unsigned v) { return __hip_atomic_fetch_add(p, v, __ATOMIC_RELAXED, __HIP_MEMORY_SCOPE_AGENT); }
__device__ __forceinline__ unsigned xb_xcc_id() { return (unsigned)__builtin_amdgcn_s_getreg((3 << 11) | 20) & 0xFu; }
#define XB_SPIN(cond, bar) do { unsigned _sp = 0; while (cond) { __builtin_amdgcn_s_sleep(1); \
    if ((++_sp & 255u) == 0u) { if (xb_ld(&(bar)[XB_TMO])) break; if (_sp > XB_SPIN_CAP) { atomicAdd(&(bar)[XB_TMO], 1u); break; } } } } while (0)

struct XcdBarrier {
    unsigned* bar; unsigned x;
    volatile LAS unsigned* st;
};

__device__ __forceinline__ XcdBarrier xcd_barrier_post(unsigned* bar, volatile LAS unsigned* st) {
    XcdBarrier b; b.bar = bar; b.x = xb_xcc_id(); b.st = st;
    if (threadIdx.x == 0) (void)xb_add(&bar[XB_XCNT(b.x)], 1u);
    return b;
}
__device__ __forceinline__ void xcd_barrier_complete(unsigned* bar, unsigned x, unsigned& nloc, unsigned& nx) {
    const unsigned G = gridDim.x * gridDim.y * gridDim.z;
    unsigned sum, cnt, mine, sp = 0u;
    for (;;) {
        sum = 0u; cnt = 0u; mine = 0u;
#pragma unroll
        for (unsigned j = 0; j < 16; ++j) { const unsigned c = xb_ld(&bar[XB_XCNT(j)]); sum += c; cnt += (c > 0u) ? 1u : 0u; mine = (j == x) ? c : mine; }
        if (sum == G) break;
        __builtin_amdgcn_s_sleep(1);
        if ((++sp & 255u) == 0u) { if (xb_ld(&bar[XB_TMO])) break; if (sp > XB_SPIN_CAP) { atomicAdd(&bar[XB_TMO], 1u); break; } }
    }
    nloc = mine > 0u ? mine : 1u; nx = cnt > 0u ? cnt : 1u;
}

__device__ __forceinline__ void xcd_barrier(const XcdBarrier& b) {
    asm volatile("s_waitcnt vmcnt(0)" ::: "memory");
    __syncthreads();
    if (threadIdx.x == 0) {
        unsigned* bar = b.bar;
        __builtin_amdgcn_s_waitcnt(0);
        unsigned nloc = b.st[0], nx = b.st[1];
        if (nloc == 0u) { xcd_barrier_complete(bar, b.x, nloc, nx); b.st[0] = nloc; b.st[1] = nx; }
        const unsigned old = xb_add(&bar[XB_XSUB(b.x)], 1u);
        const unsigned gen = old / nloc;
        if (old + 1u == (gen + 1u) * nloc) {
            __builtin_amdgcn_fence(__ATOMIC_RELEASE, "agent");
            asm volatile("s_waitcnt vmcnt(0)" ::: "memory");
            const unsigned og = xb_add(&bar[XB_TOP], 1u);
            const unsigned tg = og / nx;
            if (og + 1u == (tg + 1u) * nx) xb_add(&bar[XB_TOPGEN], 1u);
            else XB_SPIN(xb_ld(&bar[XB_TOPGEN]) == tg, bar);
            __builtin_amdgcn_fence(__ATOMIC_ACQUIRE, "agent");
            xb_add(&bar[XB_XGEN(b.x)], 1u);
            asm volatile("s_waitcnt vmcnt(0)" ::: "memory");
        } else {
            XB_SPIN(xb_ld(&bar[XB_XGEN(b.x)]) == gen, bar);
            __builtin_amdgcn_fence(__ATOMIC_ACQUIRE, "agent");
            asm volatile("s_waitcnt vmcnt(0)" ::: "memory");
        }
    }
    __syncthreads();
}

constexpr size_t WS_BAR = 65536;
struct Args { const float* in[16]; float* out; unsigned char* ws; };

__global__ void __launch_bounds__(512, 2) fwd_kernel(Args a) {
    extern __shared__ __attribute__((aligned(16))) unsigned char lds_raw[];
    LAS unsigned char* lds = (LAS unsigned char*)lds_raw;
    cgx::grid_group grid = cgx::this_grid();
    const int tid = threadIdx.x, lane = tid & 63, wave = __builtin_amdgcn_readfirstlane(tid >> 6);
    const int G = gridDim.x, bid = blockIdx.x;
    volatile LAS unsigned* bst = (volatile LAS unsigned*)(lds + 131072 + 320);
    if (tid < 2) bst[tid] = 0u;
    __syncthreads();
    const XcdBarrier bar = xcd_barrier_post((unsigned*)(a.ws + WS_BAR), bst);
#define WSL() ({ size_t z_ = 0; asm volatile("" : "+s"(z_)); a.ws + z_; })
#define PTR(T, base, off) ((T*)((base) + (off)))
    {
        const float *x_prompt = a.in[0], *x_sample = a.in[1], *rel_bias = a.in[2], *norm_g = a.in[3], *w_in = a.in[4], *lq1 = a.in[7], *lk1 = a.in[8], *lq2 = a.in[9], *lk2 = a.in[10], *w_attn_out = a.in[12], *w_conv_out = a.in[14], *w_o = a.in[15];
        unsigned char* wsp = WSL();
        float* misc = PTR(float, wsp, WS_MISC); float* part_all = PTR(float, wsp, WS_PART);
        bf16_t *WinT = PTR(bf16_t, wsp, WS_WIN), *WvT = PTR(bf16_t, wsp, WS_WV), *WaT = PTR(bf16_t, wsp, WS_WA), *WbT = PTR(bf16_t, wsp, WS_WB), *WoT = PTR(bf16_t, wsp, WS_WO), *XB_all = PTR(bf16_t, wsp, WS_XB);
        LAS float* scr = (LAS float*)(lds + wave * 8704);
        const int gw = bid * 8 + wave, NGW = G * 8;
        constexpr int IPL = 16 * ((NIN + 4 * 1024) / 32);
        for (int it = gw; it < DEPTH * IPL; it += NGW) {
            const int l = it / IPL, r = it % IPL, kb = r & 15; int nb = r >> 4;
            if (nb < NIN / 32) { tr_item(w_in + (size_t)l * DM * NPROJ, NPROJ, norm_g + l * DM, WinT + (size_t)l * NIN * DM, 1, 0, nb * 32, kb * 64, scr, lane); continue; } nb -= NIN / 32;
            if (nb < 32) { tr_item(w_in + (size_t)l * DM * NPROJ, NPROJ, norm_g + l * DM, WvT + (size_t)l * DM * DM, 0, 2048, nb * 32, kb * 64, scr, lane); continue; } nb -= 32;
            if (nb < 32) { tr_item(w_attn_out + (size_t)l * DM * DM, DM, nullptr, WaT + (size_t)l * DM * DM, 0, 0, nb * 32, kb * 64, scr, lane); continue; } nb -= 32;
            if (nb < 32) { tr_item(w_conv_out + (size_t)l * DM * DM, DM, nullptr, WbT + (size_t)l * DM * DM, 0, 0, nb * 32, kb * 64, scr, lane); continue; } nb -= 32;
            tr_item(w_o + (size_t)l * DM * DM, DM, nullptr, WoT + (size_t)l * DM * DM, 0, 0, nb * 32, kb * 64, scr, lane);
        }
#pragma unroll 2
        for (int m = gw; m < MTOT; m += NGW) {
            const float* xrow = (m < 8 * SEQL) ? x_prompt + (size_t)m * DM : x_sample + (size_t)(m - 8 * SEQL) * DM;
            f32x4 v[4]; float s = 0.f;
#pragma unroll
            for (int j = 0; j < 4; ++j) { v[j] = ld4(xrow + 4 * lane + 256 * j); const f32x4 q = v[j] * v[j]; s += (q[0] + q[1]) + (q[2] + q[3]); }
            s = wave_sum(s);
            u32x2* o8 = (u32x2*)(XB_all + (size_t)m * DM) + lane;
#pragma unroll
            for (int j = 0; j < 4; ++j) { u32x2 w; w.x = pk2(v[j][0], v[j][1]); w.y = pk2(v[j][2], v[j][3]); o8[64 * j] = w; }
            if (lane < 16) part_all[(size_t)m * 16 + lane] = (lane == 0) ? s : 0.f;
        }
        if (bid == 0) {
            if (tid < DEPTH) { float s1 = 0.f, s2 = 0.f; for (int i = 0; i < 64; ++i) { s1 += lq1[tid * 64 + i] * lk1[tid * 64 + i]; s2 += lq2[tid * 64 + i] * lk2[tid * 64 + i]; }
                misc[tid] = expf(s1) - expf(s2) + (0.8f - 0.6f * expf(-0.3f * (float)tid)); }
            for (int i = tid; i < 8 * TABN; i += 512) { const int h = i / TABN, j = i % TABN; const int rel = j - TABZ; misc[64 + i] = rel_bias[rel_bucket(rel) * 8 + h] * LOG2E; }
        }
    }
    grid.sync();

    for (int c = 0; c < NCHUNK; ++c) {
        for (int l = 0; l < DEPTH; ++l) {
            {
                unsigned char* wsp = WSL(); bf16_t* XB = PTR(bf16_t, wsp, WS_XB) + (size_t)c * MC * DM; const float* part = PTR(float, wsp, WS_PART) + (size_t)c * MC * 16;
                pg8::Gemm g{XB, PTR(bf16_t, wsp, WS_WIN) + (size_t)l * NIN * DM, MC, NIN, DM, PTR(bf16_t, wsp, WS_WV) + (size_t)l * DM * DM, XB};
                pg8::DualOrder S; S.s0.init(MC, NIN, G, bid); S.s1.init(DM, MC, G, bid); S.G = G; S.c = bid;
                typedef EpiDual<EpiInProj, EpiVT> EP;
                EP E{EpiInProj{part, wsp, a.in[5] + l * 64, a.in[6] + l * 64, a.in[13] + (size_t)l * 3 * DM}, EpiVT{part, wsp}};
                pg8::gemm_phase<EP, pg8::DualOrder, true, true>(lds, g, S, E);
            }
            xcd_barrier(bar);
            {
                unsigned char* wsp = WSL(); const float* misc = PTR(float, wsp, WS_MISC);
                bf16_t *Qb = PTR(bf16_t, wsp, WS_Q), *Kb = PTR(bf16_t, wsp, WS_K), *VTb = PTR(bf16_t, wsp, WS_VT), *GAb = PTR(bf16_t, wsp, WS_GA), *Ub = PTR(bf16_t, wsp, WS_U), *Wb = PTR(bf16_t, wsp, WS_W), *BCb = PTR(bf16_t, wsp, WS_BC);
                const float* cw = a.in[13] + (size_t)l * 3 * DM; const float* subln_g = a.in[11];
                int tid_c = threadIdx.x; asm volatile("" : "+v"(tid_c));
                for (int it = bid * 512 + tid_c; it < (MC / 64) * 2 * 128; it += G * 512) {
                    const int c8 = (it & 127) * 8, j = it >> 7, row = (j >> 1) * 64 + ((j & 1) ? 63 : 0);
                    const size_t off = (size_t)row * DM + c8;
                    const u32x4 z4 = (u32x4){0u, 0u, 0u, 0u};
                    const u32x4 pv = ((row & (SEQL - 1)) != 0) ? *(const u32x4*)(Ub + off - DM) : z4, cv = *(const u32x4*)(Ub + off), nv = ((row & (SEQL - 1)) != SEQL - 1) ? *(const u32x4*)(Ub + off + DM) : z4, wv = *(const u32x4*)(Wb + off);
                    float res[8];
#pragma unroll
                    for (int e = 0; e < 4; ++e) {
                        res[2 * e] = bflo(wv[e]) * (cw[c8 + 2 * e] * bflo(pv[e]) + cw[DM + c8 + 2 * e] * bflo(cv[e]) + cw[2 * DM + c8 + 2 * e] * bflo(nv[e]));
                        res[2 * e + 1] = bfhi(wv[e]) * (cw[c8 + 2 * e + 1] * bfhi(pv[e]) + cw[DM + c8 + 2 * e + 1] * bfhi(cv[e]) + cw[2 * DM + c8 + 2 * e + 1] * bfhi(nv[e])); }
                    u32x4 o; o.x = pkbf(res[0], res[1]); o.y = pkbf(res[2], res[3]); o.z = pkbf(res[4], res[5]); o.w = pkbf(res[6], res[7]);
                    *(u32x4*)(BCb + off) = o;
                }
                const float lam = misc[l], osc = 1.0f - (0.8f - 0.6f * expf(-0.3f * (float)l));
                const int xcd = bid & 7, slot = bid >> 3, nslot = (G + 7) >> 3;
                for (int i = 0; i < (CH_SEQ * 8) / 8; ++i) {
                    const int p = 8 * i + xcd, seq = p >> 3, h = p & 7;
                    for (int qb = slot; qb < SEQL / 128; qb += nslot)
                        att::attn_unit(lds, Qb, Kb, VTb, GAb, Qb, misc + 64 + h * TABN, lam, subln_g + l * 128, osc, seq, h, qb, (2 * slot) & 63);
                }
            }
            xcd_barrier(bar);
            {
                unsigned char* wsp = WSL();
                pg8::Gemm g{PTR(bf16_t, wsp, WS_Q), PTR(bf16_t, wsp, WS_WA) + (size_t)l * DM * DM, MC, DM, DM, PTR(bf16_t, wsp, WS_BC), PTR(bf16_t, wsp, WS_WB) + (size_t)l * DM * DM};
                pg8::DualOrder S; S.s0.init(MC, DM, G, bid); S.s1.init(MC, DM, G, bid); S.G = G; S.c = bid;
                typedef EpiDual<EpiGate<0>, EpiGate<1>> EP;
                EP E{EpiGate<0>{wsp}, EpiGate<1>{wsp}};
                pg8::gemm_phase<EP, pg8::DualOrder, true, true>(lds, g, S, E);
            }
            xcd_barrier(bar);
            {
                unsigned char* wsp = WSL(); float* xo = a.out + (size_t)c * MC * DM; const float* xin0 = (c < 2) ? a.in[0] + (size_t)c * MC * DM : a.in[1];
                pg8::Gemm g{PTR(bf16_t, wsp, WS_W), PTR(bf16_t, wsp, WS_WO) + (size_t)l * DM * DM, MC, DM, DM, nullptr, nullptr}; pg8::StaticOrder S; S.init(MC, DM, G, bid);
                EpiOut E{xin0, xo, PTR(bf16_t, wsp, WS_XB) + (size_t)c * MC * DM, PTR(float, wsp, WS_PART) + (size_t)c * MC * 16, l == 0, l == DEPTH - 1};
                pg8::gemm_phase<EpiOut, pg8::StaticOrder, true, true>(lds, g, S, E);
            }
            xcd_barrier(bar);
        }
    }
}

extern "C" void kernel_launch(void* const* d_in, const int* in_sizes, int n_in, void* d_out, int out_size, void* d_ws, size_t ws_size, hipStream_t stream) {
    static int grid = 0;
    if (grid == 0) {
        if (n_in != 16 || ws_size < WS_END) { fprintf(stderr, "kernel_launch: unexpected n_in %d or ws_size %zu (< %zu)\n", n_in, ws_size, (size_t)WS_END); grid = -1; return; }
        int dev = 0, cus = 0, per_cu = 0;
        hipGetDevice(&dev); hipDeviceGetAttribute(&cus, hipDeviceAttributeMultiprocessorCount, dev);
        if (hipFuncSetAttribute((const void*)fwd_kernel, hipFuncAttributeMaxDynamicSharedMemorySize, LDS_BYTES) != hipSuccess) { fprintf(stderr, "hipFuncSetAttribute failed\n"); grid = -1; return; }
        if (hipOccupancyMaxActiveBlocksPerMultiprocessor(&per_cu, (const void*)fwd_kernel, 512, LDS_BYTES) != hipSuccess || per_cu < 1) { fprintf(stderr, "occupancy query: %d\n", per_cu); per_cu = 1; }
        (void)hipGetLastError();
        grid = cus * 1;
    }
    if (grid < 0) return;
    if (hipMemsetAsync((char*)d_ws + WS_BAR, 0, 16384, stream) != hipSuccess) { fprintf(stderr, "memset failed\n"); return; }
    Args a{};
    for (int i = 0; i < 16; ++i) a.in[i] = (const float*)d_in[i];
    a.out = (float*)d_out; a.ws = (unsigned char*)d_ws;
    void* args[] = {&a};
    hipError_t e = hipLaunchCooperativeKernel((const void*)fwd_kernel, dim3(grid), dim3(512), args, LDS_BYTES, stream);
    if (e != hipSuccess) fprintf(stderr, "cooperative launch failed: %s (grid %d)\n", hipGetErrorString(e), grid);
}
```

```cpp
#include <hip/hip_runtime.h>
#include <hip/hip_cooperative_groups.h>
#include <cstdio>
#include <cstdint>
namespace cgx = cooperative_groups;
namespace pg8 {
#define PG8_LAS __attribute__((address_space(3)))
typedef unsigned short bf16_t;
typedef short bf16x8 __attribute__((ext_vector_type(8)));
typedef float f32x4 __attribute__((ext_vector_type(4)));
typedef unsigned u32x4 __attribute__((ext_vector_type(4)));
constexpr int BM = 256, BK = 64, HALF = 128, HTB = HALF * BK * 2  , STAGE_BYTES = 8 * HTB, NXCD = 8, WGM = 8;

__host__ __device__ __forceinline__ int lds_byte(int r, int c) { const int st = (r >> 4) * 2 + (c >> 5), rr = r & 15, cc = c & 31, ob = rr * 64 + cc * 2; return st * 1024 + (ob ^ (((ob >> 9) & 1) << 5)); }
__host__ __device__ __forceinline__ void stage_rc(int b, int& R, int& C) { const int st = b / 1024, sb = b % 1024, swz = sb ^ (((sb >> 9) & 1) << 5); R = (st >> 1) * 16 + swz / 64; C = (st & 1) * 32 + (swz % 64) / 2; }
__host__ __device__ __forceinline__ int perm32(int rho) { const int n = rho >> 4, i = rho & 15; return 8 * (i >> 2) + 4 * n + (i & 3); }

struct Unit { int pm, pn, w; };
struct Gemm { const bf16_t* A; const bf16_t* Bt; int M, N, K; const bf16_t* A2; const bf16_t* Bt2; };

struct StaticOrder {
    int nM, nN, nwg, G, c;
    __host__ __device__ void init(int M, int N, int G_, int c_) { nM = M / BM; nN = N / BM; nwg = nM * nN; G = G_; c = c_; }
    __host__ __device__ bool next(int i, Unit& u) const { return map((long)i * G + c, u); }
    __host__ __device__ bool map(long L, Unit& u) const {
        if (L >= nwg) return false; u.w = 0;
        int wgid = (int)L; { const int q = nwg / NXCD, r = nwg % NXCD, xcd = wgid % NXCD, off = wgid / NXCD; wgid = (xcd < r ? xcd * (q + 1) : r * (q + 1) + (xcd - r) * q) + off; }
        const int nig = WGM * nN, gid = wgid / nig, fm = gid * WGM, gsz = (nM - fm) < WGM ? (nM - fm) : WGM;
        u.pm = fm + ((wgid % nig) % gsz); u.pn = (wgid % nig) / gsz; return true;
    }
    __device__ __forceinline__ void a_ready(const Unit&) const {}
    __device__ __forceinline__ void done(const Unit&) const {}
};
struct DualOrder {
    StaticOrder s0, s1; int G, c;
    __host__ __device__ bool next(int i, Unit& u) const {
        long L = (long)i * G + c; const bool second = L >= s0.nwg; if (second) L -= s0.nwg;
        StaticOrder t; t.nM = second ? s1.nM : s0.nM; t.nN = second ? s1.nN : s0.nN; t.nwg = second ? s1.nwg : s0.nwg; t.G = G; t.c = c;
        const bool ok = t.map(L, u); u.w = second ? 1 : 0; return ok; }
    __device__ __forceinline__ void a_ready(const Unit&) const {}
    __device__ __forceinline__ void done(const Unit&) const {}
};

__device__ __forceinline__ unsigned cvt_pk_bf16(float lo, float hi) { unsigned r; asm volatile("v_cvt_pk_bf16_f32 %0, %1, %2" : "=v"(r) : "v"(lo), "v"(hi)); return r; }
typedef float f32x2 __attribute__((ext_vector_type(2)));
template <class Epi, class Sched, bool ALIGN_EPI = false, bool SP2 = false>
__device__ __forceinline__ void gemm_phase(PG8_LAS unsigned char* lds, const Gemm g, const Sched& S, const Epi& E) {
    int tid_l = threadIdx.x; asm volatile("" : "+v"(tid_l));
    const int tid = tid_l, wid = __builtin_amdgcn_readfirstlane(tid >> 6), lane = tid & 63, wr = wid >> 2, wc = wid & 3, fr = lane & 15, fq = lane >> 4;
    const int K = g.K, nt = K / BK;
    unsigned voffA[2], voffB[2];
#pragma unroll
    for (int i = 0; i < 2; ++i) { int R, C; stage_rc(tid * 16 + i * 8192, R, C); const int Rb = Epi::PERM ? ((R & ~31) + perm32(R & 31)) : R;
        voffA[i] = (unsigned)(R * K + C) * 2u; voffB[i] = (unsigned)(Rb * K + C) * 2u; }
    const size_t kstep = (size_t)(BK * 2);
    const size_t hstep = (size_t)HALF * K * 2;
    const size_t tstep = 2 * hstep;
    const unsigned ldsw = (unsigned)wid * 1024u;
    const int aoff = lds_byte(wr * 64 + fr, fq * 8), boff = lds_byte(wc * 32 + fr, fq * 8);
#define PG8_SA(b, h) (((b) * 2 + (h)) * HTB)
#define PG8_SB(b, h) ((4 + (b) * 2 + (h)) * HTB)
#define PG8_STAGE(bufoff, gbase, voff) do { _Pragma("unroll") for (int _i = 0; _i < 2; ++_i) \
        __builtin_amdgcn_global_load_lds((const unsigned*)((const char*)(gbase) + (voff)[_i]), (PG8_LAS unsigned*)(lds + (bufoff) + ldsw + _i * 8192), 16, 0, 0); } while (0)
#define PG8_LDA(dst, b, h) do { _Pragma("unroll") for (int m = 0; m < 4; ++m) _Pragma("unroll") for (int k = 0; k < 2; ++k) dst[m][k] = *(const PG8_LAS bf16x8*)(lds + PG8_SA(b, h) + aoff + m * 2048 + k * 1024); } while (0)
#define PG8_LDB(dst, b, h) do { _Pragma("unroll") for (int n = 0; n < 2; ++n) _Pragma("unroll") for (int k = 0; k < 2; ++k) dst[n][k] = *(const PG8_LAS bf16x8*)(lds + PG8_SB(b, h) + boff + n * 2048 + k * 1024); } while (0)
#define PG8_MMA(ai, bj, At, Bt) do { __builtin_amdgcn_s_setprio(1); _Pragma("unroll") for (int m = 0; m < 4; ++m) _Pragma("unroll") for (int n = 0; n < 2; ++n) _Pragma("unroll") for (int k = 0; k < 2; ++k) \
        acc[ai][bj][m][n] = __builtin_amdgcn_mfma_f32_16x16x32_bf16(Bt[n][k], At[m][k], acc[ai][bj][m][n], 0, 0, 0); __builtin_amdgcn_s_setprio(0); } while (0)
#define PG8_WAIT_V(n) asm volatile("s_waitcnt vmcnt(" #n ")" ::: "memory")
#define PG8_WAIT_L(n) asm volatile("s_waitcnt lgkmcnt(" #n ")" ::: "memory")
#define PG8_BAR __builtin_amdgcn_s_barrier()
#define PG8_SCHED __builtin_amdgcn_sched_barrier(0)
    Unit cur, nxt; int ui = 0;
    if (!S.next(0, cur)) return;
    f32x4 acc[2][2][4][2];
#pragma unroll
    for (int a = 0; a < 2; ++a)
#pragma unroll
        for (int b = 0; b < 2; ++b)
#pragma unroll
            for (int m = 0; m < 4; ++m)
#pragma unroll
                for (int n = 0; n < 2; ++n) acc[a][b][m][n] = (f32x4){0.f, 0.f, 0.f, 0.f};
    bf16x8 At[4][2], B0[2][2], B1[2][2];
    const char* const gA0 = (const char*)g.A; const char* const gA1 = (const char*)g.A2; const char* const gB0 = (const char*)g.Bt; const char* const gB1 = (const char*)g.Bt2;
    const char* cA = (cur.w != 0 ? gA1 : gA0) + (size_t)cur.pm * tstep; const char* cB = (cur.w != 0 ? gB1 : gB0) + (size_t)cur.pn * tstep;
    S.a_ready(cur);
    if constexpr (SP2) {
        PG8_STAGE(PG8_SB(0, 0), cB, voffB); PG8_STAGE(PG8_SB(0, 1), cB + hstep, voffB); PG8_STAGE(PG8_SA(0, 0), cA, voffA); PG8_STAGE(PG8_SA(0, 1), cA + hstep, voffA);
        if (wr == 1) PG8_BAR;
        PG8_WAIT_V(2); PG8_BAR;
        PG8_STAGE(PG8_SB(1, 0), cB + kstep, voffB); PG8_STAGE(PG8_SA(1, 0), cA + kstep, voffA); PG8_STAGE(PG8_SB(1, 1), cB + hstep + kstep, voffB);
        PG8_WAIT_V(6); PG8_BAR;
    } else {
        PG8_STAGE(PG8_SB(0, 0), cB, voffB); PG8_STAGE(PG8_SA(0, 0), cA, voffA); PG8_STAGE(PG8_SB(0, 1), cB + hstep, voffB); PG8_STAGE(PG8_SA(0, 1), cA + hstep, voffA);
        if (wr == 1) PG8_BAR;
        PG8_WAIT_V(4); PG8_BAR;
        PG8_STAGE(PG8_SB(1, 0), cB + kstep, voffB); PG8_STAGE(PG8_SA(1, 0), cA + kstep, voffA); PG8_STAGE(PG8_SB(1, 1), cB + hstep + kstep, voffB);
        PG8_WAIT_V(6); PG8_BAR;
    }
    for (;;) {
        const bool has_next = S.next(ui + 1, nxt);
        const char* nA = has_next ? (nxt.w != 0 ? gA1 : gA0) + (size_t)nxt.pm * tstep : cA; const char* nB = has_next ? (nxt.w != 0 ? gB1 : gB0) + (size_t)nxt.pn * tstep : cB;
        for (int t = 0; t < nt; t += 2) {
            const bool last = (t == nt - 2);
            const char* a1 = cA + (size_t)(t + 1) * kstep;
            const char* a2 = last ? nA : cA + (size_t)(t + 2) * kstep; const char* b2 = last ? nB : cB + (size_t)(t + 2) * kstep;
            const char* a3 = a2 + kstep; const char* b3 = b2 + kstep;
            if (last && has_next) S.a_ready(nxt);
            if constexpr (SP2) {
            PG8_LDB(B0, 0, 0); PG8_LDB(B1, 0, 1); PG8_SCHED; PG8_LDA(At, 0, 0); PG8_STAGE(PG8_SA(1, 1), a1 + hstep, voffA);
            PG8_WAIT_V(8); PG8_WAIT_L(0); PG8_BAR; PG8_MMA(0, 0, At, B0); PG8_MMA(0, 1, At, B1); PG8_BAR; PG8_SCHED;
            PG8_LDA(At, 0, 1); PG8_STAGE(PG8_SB(0, 0), b2, voffB); PG8_STAGE(PG8_SB(0, 1), b2 + hstep, voffB); PG8_STAGE(PG8_SA(0, 0), a2, voffA);
            PG8_WAIT_V(8); PG8_WAIT_L(0); PG8_BAR; PG8_MMA(1, 0, At, B0); PG8_MMA(1, 1, At, B1); PG8_BAR; PG8_SCHED;
            PG8_LDB(B0, 1, 0); PG8_LDB(B1, 1, 1); PG8_SCHED; PG8_LDA(At, 1, 0); PG8_STAGE(PG8_SA(0, 1), a2 + hstep, voffA);
            PG8_WAIT_V(8); PG8_WAIT_L(0); PG8_BAR; PG8_MMA(0, 0, At, B0); PG8_MMA(0, 1, At, B1); PG8_BAR; PG8_SCHED;
            PG8_LDA(At, 1, 1); PG8_STAGE(PG8_SB(1, 0), b3, voffB); PG8_STAGE(PG8_SB(1, 1), b3 + hstep, voffB); PG8_STAGE(PG8_SA(1, 0), a3, voffA);
            PG8_WAIT_V(8); PG8_WAIT_L(0); PG8_BAR; PG8_MMA(1, 0, At, B0); PG8_MMA(1, 1, At, B1); PG8_BAR; PG8_SCHED;
            } else {
            PG8_LDB(B0, 0, 0); PG8_SCHED; PG8_LDA(At, 0, 0); PG8_STAGE(PG8_SA(1, 1), a1 + hstep, voffA);
            PG8_WAIT_L(8); PG8_BAR; PG8_WAIT_L(0); PG8_MMA(0, 0, At, B0); PG8_BAR; PG8_SCHED;
            PG8_LDB(B1, 0, 1); PG8_STAGE(PG8_SB(0, 0), b2, voffB);
            PG8_BAR; PG8_WAIT_L(0); PG8_MMA(0, 1, At, B1); PG8_BAR;
            PG8_LDA(At, 0, 1); PG8_STAGE(PG8_SA(0, 0), a2, voffA);
            PG8_BAR; PG8_WAIT_L(0); PG8_MMA(1, 0, At, B0); PG8_BAR; PG8_SCHED;
            PG8_STAGE(PG8_SB(0, 1), b2 + hstep, voffB);
            PG8_WAIT_V(6); PG8_BAR; PG8_MMA(1, 1, At, B1); PG8_BAR;
            PG8_LDB(B0, 1, 0); PG8_SCHED; PG8_LDA(At, 1, 0); PG8_STAGE(PG8_SA(0, 1), a2 + hstep, voffA);
            PG8_WAIT_L(8); PG8_BAR; PG8_WAIT_L(0); PG8_MMA(0, 0, At, B0); PG8_BAR; PG8_SCHED;
            PG8_LDB(B1, 1, 1); PG8_STAGE(PG8_SB(1, 0), b3, voffB);
            PG8_BAR; PG8_WAIT_L(0); PG8_MMA(0, 1, At, B1); PG8_BAR;
            PG8_LDA(At, 1, 1); PG8_STAGE(PG8_SA(1, 0), a3, voffA);
            PG8_BAR; PG8_WAIT_L(0); PG8_MMA(1, 0, At, B0); PG8_BAR; PG8_SCHED;
            PG8_STAGE(PG8_SB(1, 1), b3 + hstep, voffB);
            PG8_WAIT_V(6); PG8_BAR; PG8_MMA(1, 1, At, B1); PG8_BAR;
            }
        }
        if constexpr (ALIGN_EPI) { if (wr == 0) PG8_BAR; }
        if constexpr (!Epi::AFTER_DRAIN) { E(acc, cur, wr, wc, fr, fq); S.done(cur); }
        if (!has_next) break;
#pragma unroll
        for (int a = 0; a < 2; ++a)
#pragma unroll
            for (int b = 0; b < 2; ++b)
#pragma unroll
                for (int m = 0; m < 4; ++m)
#pragma unroll
                    for (int n = 0; n < 2; ++n) acc[a][b][m][n] = (f32x4){0.f, 0.f, 0.f, 0.f};
        cur = nxt; cA = nA; cB = nB; ++ui;
        if constexpr (ALIGN_EPI) { if (wr == 1) PG8_BAR; }
    }
    PG8_WAIT_V(0);
    if constexpr (!ALIGN_EPI) { if (wr == 0) PG8_BAR; }
    PG8_BAR;
    if constexpr (Epi::AFTER_DRAIN) { E.fused(acc, cur, wr, wc, fr, fq, lds, wid, lane); S.done(cur); }
#undef PG8_SA
#undef PG8_SB
#undef PG8_STAGE
#undef PG8_LDA
#undef PG8_LDB
#undef PG8_MMA
#undef PG8_WAIT_V
#undef PG8_WAIT_L
#undef PG8_BAR
#undef PG8_SCHED
}
}
#define LAS __attribute__((address_space(3)))
typedef unsigned short bf16_t;
typedef short bf16x8 __attribute__((ext_vector_type(8)));
typedef float f32x4 __attribute__((ext_vector_type(4)));
typedef float f32x16 __attribute__((ext_vector_type(16)));
typedef unsigned u32x4 __attribute__((ext_vector_type(4)));
typedef unsigned u32x2 __attribute__((ext_vector_type(2)));
constexpr int DM = 1024, SEQL = 4096, NSEQ = 12, MTOT = NSEQ * SEQL, CH_SEQ = 4, MC = CH_SEQ * SEQL, NCHUNK = NSEQ / CH_SEQ, DEPTH = 4;
constexpr int NPROJ = 10240, NIN = 9216;
constexpr float EPS = 1e-6f, LOG2E = 1.4426950408889634f;
constexpr size_t MiB = 1u << 20;
constexpr size_t WS_MISC = 0, WS_PART = 1 * MiB, WS_WIN = 4 * MiB, WS_WV = 76 * MiB, WS_WA = 84 * MiB, WS_WB = 92 * MiB, WS_WO = 100 * MiB, WS_XB = 108 * MiB,
                 WS_Q = 204 * MiB, WS_K = 236 * MiB, WS_VT = 268 * MiB, WS_GA = 300 * MiB, WS_U = 332 * MiB, WS_W = 364 * MiB, WS_MA = 396 * MiB, WS_MB = 428 * MiB, WS_BC = 460 * MiB, WS_END = 492 * MiB;
constexpr int TABN = 640, TABZ = 320;
constexpr int LDS_BYTES = 147456;

__device__ __forceinline__ float bf2f(unsigned short b) { return __uint_as_float(((unsigned)b) << 16); }
__device__ __forceinline__ float bflo(unsigned w) { return __uint_as_float(w << 16); }
__device__ __forceinline__ float bfhi(unsigned w) { return __uint_as_float(w & 0xffff0000u); }
__device__ __forceinline__ unsigned pkbf(float lo, float hi) { return pg8::cvt_pk_bf16(lo, hi); }
__device__ __forceinline__ float fast_rcp(float x) { return __builtin_amdgcn_rcpf(x); }
__device__ __forceinline__ float sigmoidf_(float x) { return fast_rcp(1.f + __builtin_amdgcn_exp2f(-x * LOG2E)); }
__device__ __forceinline__ float siluf_(float x) { return x * sigmoidf_(x); }
__device__ __forceinline__ f32x4 ld4(const float* p) { return *(const f32x4*)p; }

__device__ __forceinline__ float row_rstd(const float* part, int row) {
    const f32x4 a = ld4(part + (size_t)row * 16), b = ld4(part + (size_t)row * 16 + 4), c = ld4(part + (size_t)row * 16 + 8), d = ld4(part + (size_t)row * 16 + 12);
    const f32x4 s = (a + b) + (c + d);
    return __builtin_amdgcn_rsqf(((s[0] + s[1]) + (s[2] + s[3])) * (1.0f / DM) + EPS);
}
struct EpiInProj {
    static constexpr bool PERM = true, AFTER_DRAIN = false;
    const float* part; unsigned char* wsb; const float *gq, *gk, *cw;
    __device__ __forceinline__ void operator()(const f32x4 (&acc)[2][2][4][2], const pg8::Unit& u, int wr, int wc, int fr, int fq) const {
        const int pn = u.pn, rowb = u.pm * 256 + wr * 64 + fr;
        if (pn < 8) {
            const bool isq = pn < 4; const float* g = isq ? gq : gk; const float cs = isq ? 0.125f * LOG2E : 1.f; bf16_t* O = (bf16_t*)(wsb + (isq ? WS_Q : WS_K));
            const int cb = (pn & 3) * 256 + 64 * wc + 8 * fq;
            f32x4 gv[2][2];
#pragma unroll
            for (int bj = 0; bj < 2; ++bj)
#pragma unroll
                for (int n = 0; n < 2; ++n) gv[bj][n] = ld4(g + 32 * bj + 8 * fq + 4 * n) * cs;
#pragma unroll
            for (int ai = 0; ai < 2; ++ai)
#pragma unroll
                for (int m = 0; m < 4; ++m) {
                    const float rsv = row_rstd(part, rowb + ai * 128 + m * 16); float ss = 0.f;
#pragma unroll
                    for (int bj = 0; bj < 2; ++bj)
#pragma unroll
                        for (int n = 0; n < 2; ++n) { const f32x4 q = acc[ai][bj][m][n] * acc[ai][bj][m][n]; ss += (q[0] + q[1]) + (q[2] + q[3]); }
                    ss += __shfl_xor(ss, 16); ss += __shfl_xor(ss, 32);
                    const float r = __builtin_amdgcn_rsqf(ss * rsv * rsv * (1.0f / 64.0f) + EPS) * rsv;
                    bf16_t* rowp = O + (size_t)(rowb + ai * 128 + m * 16) * DM + cb;
#pragma unroll
                    for (int bj = 0; bj < 2; ++bj) { const f32x4 a = acc[ai][bj][m][0] * r * gv[bj][0], b = acc[ai][bj][m][1] * r * gv[bj][1];
                        u32x4 w; w.x = pkbf(a[0], a[1]); w.y = pkbf(a[2], a[3]); w.z = pkbf(b[0], b[1]); w.w = pkbf(b[2], b[3]); *(u32x4*)(rowp + 32 * bj) = w; }
                }
        } else if (pn >= 12 && pn < 28) {
            const int ch0 = 64 * (pn - 12) + 16 * wc + 4 * fq;
            const f32x4 c0 = ld4(cw + ch0), c1 = ld4(cw + DM + ch0), c2 = ld4(cw + 2 * DM + ch0);
            bf16_t* Up = (bf16_t*)(wsb + WS_U); bf16_t* Wp = (bf16_t*)(wsb + WS_W); bf16_t* Bp = (bf16_t*)(wsb + WS_BC);
#pragma unroll
            for (int ai = 0; ai < 2; ++ai) {
                f32x4 uu[4], ww[4], up[4], un[4];
#pragma unroll
                for (int m = 0; m < 4; ++m) {
                    const float r = row_rstd(part, rowb + ai * 128 + m * 16); const f32x4 xc = acc[ai][0][m][0] * r, cg = acc[ai][0][m][1] * r, bg = acc[ai][1][m][0] * r, gb = acc[ai][1][m][1] * r;
                    uu[m] = cg * xc;
#pragma unroll
                    for (int e = 0; e < 4; ++e) { ww[m][e] = bg[e] * siluf_(gb[e]);
                        up[m][e] = __int_as_float(__builtin_amdgcn_mov_dpp(__float_as_int(uu[m][e]), 0x121, 0xf, 0xf, false));
                        un[m][e] = __int_as_float(__builtin_amdgcn_mov_dpp(__float_as_int(uu[m][e]), 0x12f, 0xf, 0xf, false)); }
                }
#pragma unroll
                for (int m = 0; m < 4; ++m) {
                    const f32x4 z = {0.f, 0.f, 0.f, 0.f};
                    const f32x4 pv = (fr == 0) ? (m > 0 ? up[m > 0 ? m - 1 : 0] : z) : up[m], nv = (fr == 15) ? (m < 3 ? un[m < 3 ? m + 1 : 3] : z) : un[m];
                    const f32x4 bc = ww[m] * (c0 * pv + c1 * uu[m] + c2 * nv);
                    const size_t off = (size_t)(rowb + ai * 128 + m * 16) * DM + ch0;
                    const bool bnd = (m == 0 && fr == 0) || (m == 3 && fr == 15);
                    if (!bnd) { u32x2 o; o.x = pkbf(bc[0], bc[1]); o.y = pkbf(bc[2], bc[3]); *(u32x2*)(Bp + off) = o; }
                    if ((m == 0 && fr <= 1) || (m == 3 && fr >= 14)) {
                        u32x2 a; a.x = pkbf(uu[m][0], uu[m][1]); a.y = pkbf(uu[m][2], uu[m][3]); *(u32x2*)(Up + off) = a;
                        u32x2 b; b.x = pkbf(ww[m][0], ww[m][1]); b.y = pkbf(ww[m][2], ww[m][3]); *(u32x2*)(Wp + off) = b; }
                }
            }
        } else {
            const bool isga = pn < 12; bf16_t* O = (bf16_t*)(wsb + (isga ? WS_GA : (pn < 32 ? WS_MA : WS_MB))); const int t = isga ? pn - 8 : ((pn - 28) & 3);
            const int cb = t * 256 + 64 * wc + 8 * fq;
#pragma unroll
            for (int ai = 0; ai < 2; ++ai)
#pragma unroll
                for (int m = 0; m < 4; ++m) {
                    bf16_t* rowp = O + (size_t)(rowb + ai * 128 + m * 16) * DM + cb; const float rsv = row_rstd(part, rowb + ai * 128 + m * 16);
#pragma unroll
                    for (int bj = 0; bj < 2; ++bj) { f32x4 a = acc[ai][bj][m][0] * rsv, b = acc[ai][bj][m][1] * rsv;
#pragma unroll
                        for (int e = 0; e < 4; ++e) { const float sa = sigmoidf_(a[e]), sb = sigmoidf_(b[e]); a[e] = isga ? a[e] * sa : sa; b[e] = isga ? b[e] * sb : sb; }
                        u32x4 w; w.x = pkbf(a[0], a[1]); w.y = pkbf(a[2], a[3]); w.z = pkbf(b[0], b[1]); w.w = pkbf(b[2], b[3]); *(u32x4*)(rowp + 32 * bj) = w; }
                }
        }
    }
};
struct EpiVT {
    static constexpr bool PERM = true, AFTER_DRAIN = false;
    const float* part; unsigned char* wsb;
    __device__ __forceinline__ void operator()(const f32x4 (&acc)[2][2][4][2], const pg8::Unit& u, int wr, int wc, int fr, int fq) const {
        const int cb = u.pn * 256 + 32 * wc + 8 * fq, rowb = u.pm * 256 + wr * 64 + fr;
        f32x4 rs[2][2];
#pragma unroll
        for (int bj = 0; bj < 2; ++bj)
#pragma unroll
            for (int n = 0; n < 2; ++n)
#pragma unroll
                for (int e = 0; e < 4; ++e) rs[bj][n][e] = row_rstd(part, cb + 128 * bj + 4 * n + e);
#pragma unroll
        for (int ai = 0; ai < 2; ++ai)
#pragma unroll
            for (int m = 0; m < 4; ++m) { bf16_t* rowp = (bf16_t*)(wsb + WS_VT) + (size_t)(rowb + ai * 128 + m * 16) * MC + cb;
#pragma unroll
                for (int bj = 0; bj < 2; ++bj) { const f32x4 a = acc[ai][bj][m][0] * rs[bj][0], b = acc[ai][bj][m][1] * rs[bj][1];
                    u32x4 w; w.x = pkbf(a[0], a[1]); w.y = pkbf(a[2], a[3]); w.z = pkbf(b[0], b[1]); w.w = pkbf(b[2], b[3]); *(u32x4*)(rowp + 128 * bj) = w; } }
    }
};
template <int MODE> struct EpiGate {
    static constexpr bool PERM = true, AFTER_DRAIN = false;
    unsigned char* wsb;
    __device__ __forceinline__ void operator()(const f32x4 (&acc)[2][2][4][2], const pg8::Unit& u, int wr, int wc, int fr, int fq) const {
        const int cb = u.pn * 256 + 32 * wc + 8 * fq, rowb = u.pm * 256 + wr * 64 + fr;
        const bf16_t* G = (const bf16_t*)(wsb + (MODE ? WS_MB : WS_MA)); const bf16_t* Tin = (const bf16_t*)(wsb + WS_U); bf16_t* O = (bf16_t*)(wsb + (MODE ? WS_W : WS_U));
#pragma unroll
        for (int ai = 0; ai < 2; ++ai)
#pragma unroll
            for (int m = 0; m < 4; ++m) { const size_t off = (size_t)(rowb + ai * 128 + m * 16) * DM + cb;
#pragma unroll
                for (int bj = 0; bj < 2; ++bj) { const u32x4 g = *(const u32x4*)(G + off + 128 * bj); const f32x4 a = acc[ai][bj][m][0], b = acc[ai][bj][m][1];
                    float r[8] = {a[0] * bflo(g.x), a[1] * bfhi(g.x), a[2] * bflo(g.y), a[3] * bfhi(g.y), b[0] * bflo(g.z), b[1] * bfhi(g.z), b[2] * bflo(g.w), b[3] * bfhi(g.w)};
                    if (MODE == 1) { const u32x4 t = *(const u32x4*)(Tin + off + 128 * bj);
                        r[0] += bflo(t.x); r[1] += bfhi(t.x); r[2] += bflo(t.y); r[3] += bfhi(t.y); r[4] += bflo(t.z); r[5] += bfhi(t.z); r[6] += bflo(t.w); r[7] += bfhi(t.w); }
                    u32x4 w; w.x = pkbf(r[0], r[1]); w.y = pkbf(r[2], r[3]); w.z = pkbf(r[4], r[5]); w.w = pkbf(r[6], r[7]); *(u32x4*)(O + off + 128 * bj) = w; } }
    }
};
struct EpiOut {
    static constexpr bool PERM = true, AFTER_DRAIN = false;
    const float* xin; float* xout; bf16_t* XB; float* part; int first, last;
    __device__ __forceinline__ void operator()(const f32x4 (&acc)[2][2][4][2], const pg8::Unit& u, int wr, int wc, int fr, int fq) const {
        const int cb = u.pn * 256 + 32 * wc + 8 * fq, rowb = u.pm * 256 + wr * 64 + fr;
#pragma unroll
        for (int ai = 0; ai < 2; ++ai)
#pragma unroll
            for (int m = 0; m < 4; ++m) { const int row = rowb + ai * 128 + m * 16; const size_t off = (size_t)row * DM + cb; float ss = 0.f;
#pragma unroll
                for (int bj = 0; bj < 2; ++bj) { f32x4 a = acc[ai][bj][m][0], b = acc[ai][bj][m][1];
                    if (first) { a = a + ld4(xin + off + 128 * bj); b = b + ld4(xin + off + 128 * bj + 4); }
                    else { const u32x4 xb = *(const u32x4*)(XB + off + 128 * bj);
                        a = a + (f32x4){bflo(xb.x), bfhi(xb.x), bflo(xb.y), bfhi(xb.y)}; b = b + (f32x4){bflo(xb.z), bfhi(xb.z), bflo(xb.w), bfhi(xb.w)}; }
                    if (last) { *(f32x4*)(xout + off + 128 * bj) = a; *(f32x4*)(xout + off + 128 * bj + 4) = b; }
                    else { u32x4 w; w.x = pkbf(a[0], a[1]); w.y = pkbf(a[2], a[3]); w.z = pkbf(b[0], b[1]); w.w = pkbf(b[2], b[3]); *(u32x4*)(XB + off + 128 * bj) = w;
                        const f32x4 qa = a * a, qb = b * b; ss += ((qa[0] + qa[1]) + (qa[2] + qa[3])) + ((qb[0] + qb[1]) + (qb[2] + qb[3])); } }
                if (!last) { ss += __shfl_xor(ss, 16); ss += __shfl_xor(ss, 32);
                    if (fq == 0) part[(size_t)row * 16 + u.pn * 4 + wc] = ss; } }
    }
};

template <class E0, class E1> struct EpiDual {
    static constexpr bool PERM = true, AFTER_DRAIN = false;
    E0 e0; E1 e1;
    __device__ __forceinline__ void operator()(const f32x4 (&acc)[2][2][4][2], const pg8::Unit& u, int wr, int wc, int fr, int fq) const { if (u.w) e1(acc, u, wr, wc, fr, fq); else e0(acc, u, wr, wc, fr, fq); }
};
namespace att {
constexpr int KP = 256, VP = 128, KBY = 64 * KP, VBY = 128 * VP;
constexpr int OFF_TAB = 69632, OFF_L = OFF_TAB + 2560, XP = 132;
__device__ __forceinline__ int crow(int r, int hi) { return (r & 3) + 8 * (r >> 2) + 4 * hi; }
__device__ __forceinline__ bf16x8 pack8(const f32x16& p, int b) {
    u32x4 w; w.x = pkbf(p[b], p[b + 1]); w.y = pkbf(p[b + 2], p[b + 3]); w.z = pkbf(p[b + 4], p[b + 5]); w.w = pkbf(p[b + 6], p[b + 7]); return __builtin_bit_cast(bf16x8, w); }
__device__ __forceinline__ void attn_unit(LAS unsigned char* lds, const bf16_t* Q, const bf16_t* K, const bf16_t* VT, const bf16_t* GA, bf16_t* O, const float* tabg,
                                          float lam, const float* subg, float osc, int seq, int h, int qb, int rot) {
    int tid_l = threadIdx.x; asm volatile("" : "+v"(tid_l));
    const int tid = tid_l, lane = tid & 63, r32 = lane & 31, hi = lane >> 5, wid = __builtin_amdgcn_readfirstlane(tid >> 6), sm = wid >> 2, qg = wid & 3;
    const int tok0 = seq * SEQL, q0 = qb * 128;
    LAS float* tabl = (LAS float*)(lds + OFF_TAB);
    for (int i = tid; i < TABN; i += 512) tabl[i] = tabg[i];
    const float b_lo = tabg[0], b_hi = tabg[TABN - 1];
    bf16x8 qf[4];
    { const bf16_t* qp = Q + (size_t)(tok0 + q0 + qg * 32 + r32) * DM + h * 128 + sm * 64 + hi * 8;
#pragma unroll
      for (int d0 = 0; d0 < 4; ++d0) qf[d0] = *(const bf16x8*)(qp + d0 * 16); }
    const bf16_t* kg[2]; const bf16_t* vg[2];
#pragma unroll
    for (int i = 0; i < 2; ++i) { const int pc = 2 * wid + i;
        { const int row = 4 * pc + (lane >> 4), c = (lane & 15) ^ (row & 15); kg[i] = K + (size_t)(tok0 + row) * DM + h * 128 + c * 8; }
        { const int row = 8 * pc + (lane >> 3), c = (lane & 7) ^ ((row >> 1) & 7); vg[i] = VT + (size_t)(h * 128 + row) * MC + tok0 + c * 8; } }
#define ATT_DMA_K(tile, kbo) do { _Pragma("unroll") for (int i = 0; i < 2; ++i) \
        __builtin_amdgcn_global_load_lds((const unsigned*)(kg[i] + (size_t)(tile) * 64 * DM), (LAS unsigned*)(lds + (kbo) + (2 * wid + i) * 1024), 16, 0, 0); } while (0)
#define ATT_DMA_V(tile, vbo) do { _Pragma("unroll") for (int i = 0; i < 2; ++i) \
        __builtin_amdgcn_global_load_lds((const unsigned*)(vg[i] + (tile) * 64), (LAS unsigned*)(lds + 2 * KBY + (vbo) + (2 * wid + i) * 1024), 16, 0, 0); } while (0)
    ATT_DMA_K(rot, 0); ATT_DMA_V(rot, 0); ATT_DMA_K((rot + 1) & 63, KBY);
    asm volatile("s_waitcnt vmcnt(0)" ::: "memory");
    __syncthreads();
    f32x16 o[4];
#pragma unroll
    for (int d0 = 0; d0 < 4; ++d0)
#pragma unroll
        for (int r = 0; r < 16; ++r) o[d0][r] = 0.f;
    float l = 0.f; int cc = 1;
    const int kact = (r32 & 19) | ((r32 & 4) << 1) | ((r32 & 8) >> 1);
    int kofs[4], vofs[4];
#pragma unroll
    for (int d0 = 0; d0 < 4; ++d0) { kofs[d0] = kact * KP + (((sm * 8 + 2 * d0 + hi) ^ (kact & 15)) << 4); vofs[d0] = 2 * KBY + r32 * VP + (((2 * d0 + hi) ^ ((r32 >> 1) & 7)) << 4); }
    const int qpos = q0 + qg * 32 + r32;
#define ATT_CLASS(k0) (((k0) + 63 <= q0 + qg * 32 - 91) ? 0 : (((k0) >= q0 + qg * 32 + 31 + 91) ? 2 : 1))
#define ATT_EV(c) ((c) == 0 ? b_lo : ((c) == 2 ? b_hi : 0.f))
#define ATT_SBAR() __builtin_amdgcn_sched_barrier(0)
#define ATT_EXP4(P, b) do { P[(b)] = __builtin_amdgcn_exp2f(P[(b)]); P[(b) + 1] = __builtin_amdgcn_exp2f(P[(b) + 1]); P[(b) + 2] = __builtin_amdgcn_exp2f(P[(b) + 2]); P[(b) + 3] = __builtin_amdgcn_exp2f(P[(b) + 3]); } while (0)
#define ATT_S01(N0, N1, k0, a0_, a1_) do { \
        if (ATT_CLASS(k0) == 1) { \
            const LAS float* tb_ = tabl + ((k0) + 8 * hi - qpos + TABZ);     \
            _Pragma("unroll") for (int r = 0; r < 16; ++r) { N0[r] = tb_[16 * (r >> 3) + (r & 7)]; N1[r] = tb_[16 * (r >> 3) + (r & 7) + 32]; } \
            N0 = __builtin_amdgcn_mfma_f32_32x32x16_bf16(a0_, qf[0], N0, 0, 0, 0); N1 = __builtin_amdgcn_mfma_f32_32x32x16_bf16(a1_, qf[0], N1, 0, 0, 0); \
        } else { const f32x16 z_ = {0.f, 0.f, 0.f, 0.f, 0.f, 0.f, 0.f, 0.f, 0.f, 0.f, 0.f, 0.f, 0.f, 0.f, 0.f, 0.f}; \
            N0 = __builtin_amdgcn_mfma_f32_32x32x16_bf16(a0_, qf[0], z_, 0, 0, 0); N1 = __builtin_amdgcn_mfma_f32_32x32x16_bf16(a1_, qf[0], z_, 0, 0, 0); } } while (0)
#define ATT_STEP(C0, C1, N0, N1, T) do { \
        const int t_ = (T), k0_ = ((t_ + rot) & 63) * 64, k1_ = ((t_ + 1 + rot) & 63) * 64; \
        { const int cn_ = ATT_CLASS(k0_); if (cn_ != cc) { const float sc = __builtin_amdgcn_exp2f(ATT_EV(cc) - ATT_EV(cn_)); \
            _Pragma("unroll") for (int d0 = 0; d0 < 4; ++d0) o[d0] = o[d0] * sc; \
            l *= sc; cc = cn_; } } \
        const LAS unsigned char* kb = lds + ((t_ + 1) & 1) * KBY; \
        { bf16x8 ka0_ = *(const LAS bf16x8*)(kb + kofs[0]), ka1_ = *(const LAS bf16x8*)(kb + kofs[0] + 32 * KP); bf16x8 ka[6]; \
          _Pragma("unroll") for (int d0 = 1; d0 < 4; ++d0) { ka[2 * d0 - 2] = *(const LAS bf16x8*)(kb + kofs[d0]); ka[2 * d0 - 1] = *(const LAS bf16x8*)(kb + kofs[d0] + 32 * KP); } \
          ATT_EXP4(C0, 0); ATT_EXP4(C1, 0); \
          ATT_SBAR(); \
          ATT_S01(N0, N1, k1_, ka0_, ka1_); \
          ATT_SBAR(); \
          _Pragma("unroll") for (int d0 = 1; d0 < 4; ++d0) { \
              N0 = __builtin_amdgcn_mfma_f32_32x32x16_bf16(ka[2 * d0 - 2], qf[d0], N0, 0, 0, 0); ATT_EXP4(C0, 4 * d0); \
              N1 = __builtin_amdgcn_mfma_f32_32x32x16_bf16(ka[2 * d0 - 1], qf[d0], N1, 0, 0, 0); ATT_EXP4(C1, 4 * d0); } \
          _Pragma("unroll") for (int g_ = 0; g_ < 6; ++g_) { __builtin_amdgcn_sched_group_barrier(0x008, 1, 0); __builtin_amdgcn_sched_group_barrier(0x400, 4, 0); } } \
        ATT_SBAR(); \
        ATT_DMA_K((t_ + 2 + rot) & 63, (t_ & 1) * KBY); ATT_DMA_V((t_ + 1 + rot) & 63, ((t_ + 1) & 1) * VBY);     \
        { bf16x8 pa[4]; pa[0] = pack8(C0, 0); pa[1] = pack8(C0, 8); pa[2] = pack8(C1, 0); pa[3] = pack8(C1, 8); \
          { float s_[4]; \
            _Pragma("unroll") for (int r = 0; r < 4; ++r) s_[r] = C0[r] + C1[r]; \
            _Pragma("unroll") for (int r = 4; r < 16; ++r) s_[r & 3] += C0[r] + C1[r]; \
            l += (s_[0] + s_[1]) + (s_[2] + s_[3]); } \
          ATT_SBAR(); \
          const LAS unsigned char* vb = lds + (t_ & 1) * VBY; \
          bf16x8 v0[4], v1[4]; \
          _Pragma("unroll") for (int d0 = 0; d0 < 4; ++d0) v0[d0] = *(const LAS bf16x8*)(vb + vofs[0] + d0 * 32 * VP); \
          _Pragma("unroll") for (int d0 = 0; d0 < 4; ++d0) v1[d0] = *(const LAS bf16x8*)(vb + vofs[1] + d0 * 32 * VP); \
          _Pragma("unroll") for (int d0 = 0; d0 < 4; ++d0) o[d0] = __builtin_amdgcn_mfma_f32_32x32x16_bf16(pa[0], v0[d0], o[d0], 0, 0, 0); \
          _Pragma("unroll") for (int d0 = 0; d0 < 4; ++d0) v0[d0] = *(const LAS bf16x8*)(vb + vofs[2] + d0 * 32 * VP); \
          _Pragma("unroll") for (int d0 = 0; d0 < 4; ++d0) o[d0] = __builtin_amdgcn_mfma_f32_32x32x16_bf16(pa[1], v1[d0], o[d0], 0, 0, 0); \
          _Pragma("unroll") for (int d0 = 0; d0 < 4; ++d0) v1[d0] = *(const LAS bf16x8*)(vb + vofs[3] + d0 * 32 * VP); \
          _Pragma("unroll") for (int d0 = 0; d0 < 4; ++d0) o[d0] = __builtin_amdgcn_mfma_f32_32x32x16_bf16(pa[2], v0[d0], o[d0], 0, 0, 0); \
          _Pragma("unroll") for (int d0 = 0; d0 < 4; ++d0) o[d0] = __builtin_amdgcn_mfma_f32_32x32x16_bf16(pa[3], v1[d0], o[d0], 0, 0, 0); \
          __builtin_amdgcn_sched_group_barrier(0x100, 8, 0); \
          _Pragma("unroll") for (int j = 0; j < 8; ++j) { __builtin_amdgcn_sched_group_barrier(0x008, 1, 0); __builtin_amdgcn_sched_group_barrier(0x100, 1, 0); } \
          __builtin_amdgcn_sched_group_barrier(0x008, 8, 0); } \
        ATT_SBAR(); \
        asm volatile("s_waitcnt vmcnt(0)" ::: "memory"); \
        __syncthreads(); \
    } while (0)
    f32x16 pA0, pA1, pB0, pB1;
    {
        const LAS unsigned char* kb = lds; const int k00 = rot * 64;
        const bf16x8 b0_ = *(const LAS bf16x8*)(kb + kofs[0]), b1_ = *(const LAS bf16x8*)(kb + kofs[0] + 32 * KP);
        ATT_S01(pA0, pA1, k00, b0_, b1_);
#pragma unroll
        for (int d0 = 1; d0 < 4; ++d0) { const bf16x8 a0 = *(const LAS bf16x8*)(kb + kofs[d0]), a1 = *(const LAS bf16x8*)(kb + kofs[d0] + 32 * KP);
            pA0 = __builtin_amdgcn_mfma_f32_32x32x16_bf16(a0, qf[d0], pA0, 0, 0, 0); pA1 = __builtin_amdgcn_mfma_f32_32x32x16_bf16(a1, qf[d0], pA1, 0, 0, 0); }
    }
    __syncthreads();
    for (int t = 0; t < 64; t += 2) {
        ATT_STEP(pA0, pA1, pB0, pB1, t);
        ATT_STEP(pB0, pB1, pA0, pA1, t + 1);
    }
#undef ATT_STEP
#undef ATT_DMA_K
#undef ATT_DMA_V
#undef ATT_S01
#undef ATT_EXP4
#undef ATT_SBAR
#undef ATT_CLASS
#undef ATT_EV
    l += __shfl_xor(l, 32);
    LAS float* Ls = (LAS float*)(lds + OFF_L) + wid * 32;
    if (hi == 0) Ls[r32] = l;
    asm volatile("s_waitcnt lgkmcnt(0)" ::: "memory");
    float inv[16];
#pragma unroll
    for (int r = 0; r < 16; ++r) inv[r] = (sm ? lam : 1.f) * fast_rcp(Ls[crow(r, hi)]);
    LAS float* X = (LAS float*)lds + qg * (32 * XP);
    if (sm == 1) {
#pragma unroll
        for (int d0 = 0; d0 < 4; ++d0)
#pragma unroll
            for (int r = 0; r < 16; ++r) X[crow(r, hi) * XP + d0 * 32 + r32] = o[d0][r] * inv[r];
    }
    __syncthreads();
    if (sm == 0) {
#pragma unroll
        for (int d0 = 0; d0 < 4; ++d0)
#pragma unroll
            for (int r = 0; r < 16; ++r) { const int ix = crow(r, hi) * XP + d0 * 32 + r32; X[ix] = o[d0][r] * inv[r] - X[ix]; }
        asm volatile("s_waitcnt lgkmcnt(0)" ::: "memory");
        const LAS float* xr = X + r32 * XP + hi * 64;
        f32x4 xv[16]; float ss = 0.f;
#pragma unroll
        for (int j = 0; j < 16; ++j) { xv[j] = *(const LAS f32x4*)(xr + 4 * j); const f32x4 q = xv[j] * xv[j]; ss += (q[0] + q[1]) + (q[2] + q[3]); }
        ss += __shfl_xor(ss, 32);
        const float rstd = __builtin_amdgcn_rsqf(ss * (1.0f / 128.0f) + EPS) * osc;
        const size_t off = (size_t)(tok0 + q0 + qg * 32 + r32) * DM + h * 128 + hi * 64;
#pragma unroll
        for (int j = 0; j < 8; ++j) { const u32x4 g = *(const u32x4*)(GA + off + 8 * j); const f32x4 s0 = ld4(subg + hi * 64 + 8 * j), s1 = ld4(subg + hi * 64 + 8 * j + 4);
            const f32x4 a = xv[2 * j] * rstd * s0, b = xv[2 * j + 1] * rstd * s1;
            u32x4 w; w.x = pkbf(a[0] * bflo(g.x), a[1] * bfhi(g.x)); w.y = pkbf(a[2] * bflo(g.y), a[3] * bfhi(g.y)); w.z = pkbf(b[0] * bflo(g.z), b[1] * bfhi(g.z)); w.w = pkbf(b[2] * bflo(g.w), b[3] * bfhi(g.w));
            *(u32x4*)(O + off + 8 * j) = w; }
    }
    __syncthreads();
}
}
__device__ __forceinline__ unsigned f2bf(float f) { unsigned u = __builtin_bit_cast(unsigned, f); return (u + 0x7fffu + ((u >> 16) & 1u)) >> 16; }
__device__ __forceinline__ unsigned pk2(float lo, float hi) { return f2bf(lo) | (f2bf(hi) << 16); }
__device__ __forceinline__ int win_srccol(int gr) {
    const int pn = gr >> 8, gc = gr & 255, bj = gc >> 7, wc = (gc >> 5) & 3, j = gc & 31, lc = 64 * wc + 32 * bj + j;
    if (pn < 4) return 256 * pn + lc;
    if (pn < 8) return 1024 + 256 * (pn - 4) + lc;
    if (pn < 12) return 3072 + 256 * (pn - 8) + lc;
    if (pn < 28) { const int fq = (j >> 3) & 3, n = (j >> 2) & 1, e = j & 3; return 4096 + (2 * bj + n) * 1024 + 64 * (pn - 12) + 16 * wc + 4 * fq + e; }
    if (pn < 32) return 8192 + 256 * (pn - 28) + lc;
    return 9216 + 256 * (pn - 32) + lc;
}
struct TrDesc { const float* W; const float* gf; bf16_t* WT; int ldw, kind, coff, n0, k0; };
__device__ __forceinline__ void tr_load(const TrDesc& d, f32x4 (&v)[8], int lane) {
    const int n4 = lane & 7, kr = lane >> 3, src = d.kind ? win_srccol(d.n0 + 4 * n4) : d.coff + d.n0 + 4 * n4;
#pragma unroll
    for (int i = 0; i < 8; ++i) { const int kk = 8 * i + kr; v[i] = ld4(d.W + (size_t)(d.k0 + kk) * d.ldw + src); if (d.gf) v[i] = v[i] * d.gf[d.k0 + kk]; }
}
__device__ __forceinline__ void tr_finish(const TrDesc& d, const f32x4 (&v)[8], LAS float* scr, int lane) {
    const int n4 = lane & 7, kr = lane >> 3;
#pragma unroll
    for (int i = 0; i < 8; ++i) { const int kk = 8 * i + kr; scr[kk * 33 + 4 * n4] = v[i][0]; scr[kk * 33 + 4 * n4 + 1] = v[i][1]; scr[kk * 33 + 4 * n4 + 2] = v[i][2]; scr[kk * 33 + 4 * n4 + 3] = v[i][3]; }
    asm volatile("s_waitcnt lgkmcnt(0)" ::: "memory");
    const int c = lane & 7;
#pragma unroll
    for (int j = 0; j < 4; ++j) { const int n = (lane >> 3) + 8 * j; const LAS float* s = scr + (8 * c) * 33 + n;
        u32x4 o; o.x = pk2(s[0 * 33], s[1 * 33]); o.y = pk2(s[2 * 33], s[3 * 33]); o.z = pk2(s[4 * 33], s[5 * 33]); o.w = pk2(s[6 * 33], s[7 * 33]);
        *(u32x4*)(d.WT + (size_t)(d.n0 + n) * DM + d.k0 + 8 * c) = o; }
    asm volatile("s_waitcnt lgkmcnt(0)" ::: "memory");
}
__device__ __forceinline__ float wave_sum(float v) {
#pragma unroll
    for (int o = 1; o < 64; o <<= 1) v += __shfl_xor(v, o);
    return v;
}
__device__ __forceinline__ int rel_bucket(int rel) {
    const int n = rel < 0 ? -rel : rel; int b;
    if (n < 8) b = n; else if (n < 12) b = 8; else if (n < 16) b = 9; else if (n < 23) b = 10; else if (n < 32) b = 11; else if (n < 46) b = 12; else if (n < 64) b = 13; else if (n < 91) b = 14; else b = 15;
    return (rel > 0 ? 16 : 0) + b;
}

#define XB_TMO      128
#define XB_XCNT(j)  (256  + 64 * (j))
#define XB_XSUB(j)  (1280 + 64 * (j))
#define XB_XGEN(j)  (2304 + 64 * (j))
#define XB_TOP      3328
#define XB_TOPGEN   3392
#define XCD_BAR_WORDS 3456
#define XB_SPIN_CAP (1u << 18)

__device__ __forceinline__ unsigned xb_ld(unsigned* p)              { return __hip_atomic_load(p, __ATOMIC_RELAXED, __HIP_MEMORY_SCOPE_AGENT); }
__device__ __forceinline__ unsigned xb_add(unsigned* p, unsigned v) { return __hip_atomic_fetch_add(p, v, __ATOMIC_RELAXED, __HIP_MEMORY_SCOPE_AGENT); }
__device__ __forceinline__ unsigned xb_xcc_id() { return (unsigned)__builtin_amdgcn_s_getreg((3 << 11) | 20) & 0xFu; }
#define XB_SPIN(cond, bar) do { unsigned _sp = 0; while (cond) { __builtin_amdgcn_s_sleep(1); \
    if ((++_sp & 255u) == 0u) { if (xb_ld(&(bar)[XB_TMO])) break; if (_sp > XB_SPIN_CAP) { atomicAdd(&(bar)[XB_TMO], 1u); break; } } } } while (0)

struct XcdBarrier {
    unsigned* bar; unsigned x;
    volatile LAS unsigned* st;
};

__device__ __forceinline__ XcdBarrier xcd_barrier_post(unsigned* bar, volatile LAS unsigned* st) {
    XcdBarrier b; b.bar = bar; b.x = xb_xcc_id(); b.st = st;
    if (threadIdx.x == 0) (void)xb_add(&bar[XB_XCNT(b.x)], 1u);
    return b;
}
__device__ __forceinline__ void xcd_barrier_complete(unsigned* bar, unsigned x, unsigned& nloc, unsigned& nx) {
    const unsigned G = gridDim.x * gridDim.y * gridDim.z;
    unsigned sum, cnt, mine, sp = 0u;
    for (;;) {
        sum = 0u; cnt = 0u; mine = 0u;
#pragma unroll
        for (unsigned j = 0; j < 16; ++j) { const unsigned c = xb_ld(&bar[XB_XCNT(j)]); sum += c; cnt += (c > 0u) ? 1u : 0u; mine = (j == x) ? c : mine; }
        if (sum == G) break;
        __builtin_amdgcn_s_sleep(1);
        if ((++sp & 255u) == 0u) { if (xb_ld(&bar[XB_TMO])) break; if (sp > XB_SPIN_CAP) { atomicAdd(&bar[XB_TMO], 1u); break; } }
    }
    nloc = mine > 0u ? mine : 1u; nx = cnt > 0u ? cnt : 1u;
}

__device__ __forceinline__ void xcd_barrier(const XcdBarrier& b) {
    asm volatile("s_waitcnt vmcnt(0)" ::: "memory");
    __syncthreads();
    if (threadIdx.x == 0) {
        unsigned* bar = b.bar;
        __builtin_amdgcn_s_waitcnt(0);
        unsigned nloc = b.st[0], nx = b.st[1];
        if (nloc == 0u) { xcd_barrier_complete(bar, b.x, nloc, nx); b.st[0] = nloc; b.st[1] = nx; }
        const unsigned old = xb_add(&bar[XB_XSUB(b.x)], 1u);
        const unsigned gen = old / nloc;
        if (old + 1u == (gen + 1u) * nloc) {
            __builtin_amdgcn_fence(__ATOMIC_RELEASE, "agent");
            asm volatile("s_waitcnt vmcnt(0)" ::: "memory");
            const unsigned og = xb_add(&bar[XB_TOP], 1u);
            const unsigned tg = og / nx;
            if (og + 1u == (tg + 1u) * nx) xb_add(&bar[XB_TOPGEN], 1u);
            else XB_SPIN(xb_ld(&bar[XB_TOPGEN]) == tg, bar);
            __builtin_amdgcn_fence(__ATOMIC_ACQUIRE, "agent");
            xb_add(&bar[XB_XGEN(b.x)], 1u);
            asm volatile("s_waitcnt vmcnt(0)" ::: "memory");
        } else {
            XB_SPIN(xb_ld(&bar[XB_XGEN(b.x)]) == gen, bar);
            __builtin_amdgcn_fence(__ATOMIC_ACQUIRE, "agent");
            asm volatile("s_waitcnt vmcnt(0)" ::: "memory");
        }
    }
    __syncthreads();
}

constexpr size_t WS_BAR = 65536;
struct Args { const float* in[16]; float* out; unsigned char* ws; };

__global__ void __launch_bounds__(512, 2) fwd_kernel(Args a) {
    extern __shared__ __attribute__((aligned(16))) unsigned char lds_raw[];
    LAS unsigned char* lds = (LAS unsigned char*)lds_raw;
    cgx::grid_group grid = cgx::this_grid();
    const int tid = threadIdx.x, lane = tid & 63, wave = __builtin_amdgcn_readfirstlane(tid >> 6);
    const int G = gridDim.x, bid = blockIdx.x;
    volatile LAS unsigned* bst = (volatile LAS unsigned*)(lds + 131072 + 320);
    if (tid < 2) bst[tid] = 0u;
    __syncthreads();
    const XcdBarrier bar = xcd_barrier_post((unsigned*)(a.ws + WS_BAR), bst);
#define WSL() ({ size_t z_ = 0; asm volatile("" : "+s"(z_)); a.ws + z_; })
#define PTR(T, base, off) ((T*)((base) + (off)))
    {
        const float *x_prompt = a.in[0], *x_sample = a.in[1], *rel_bias = a.in[2], *norm_g = a.in[3], *w_in = a.in[4], *lq1 = a.in[7], *lk1 = a.in[8], *lq2 = a.in[9], *lk2 = a.in[10], *w_attn_out = a.in[12], *w_conv_out = a.in[14], *w_o = a.in[15];
        unsigned char* wsp = WSL();
        float* misc = PTR(float, wsp, WS_MISC); float* part_all = PTR(float, wsp, WS_PART);
        bf16_t *WinT = PTR(bf16_t, wsp, WS_WIN), *WvT = PTR(bf16_t, wsp, WS_WV), *WaT = PTR(bf16_t, wsp, WS_WA), *WbT = PTR(bf16_t, wsp, WS_WB), *WoT = PTR(bf16_t, wsp, WS_WO), *XB_all = PTR(bf16_t, wsp, WS_XB);
        LAS float* scr = (LAS float*)(lds + wave * 8704);
        const int gw = bid * 8 + wave, NGW = G * 8;
        constexpr int IPL = 16 * ((NIN + 4 * 1024) / 32);
#define TR_DECODE(d, it_) do { const int l_ = (it_) / IPL, r_ = (it_) % IPL, kb_ = r_ & 15; int nb_ = r_ >> 4; d.k0 = kb_ * 64; d.kind = 0; d.coff = 0; d.gf = nullptr; d.ldw = DM; \
            if (nb_ < NIN / 32) { d.W = w_in + (size_t)l_ * DM * NPROJ; d.ldw = NPROJ; d.gf = norm_g + l_ * DM; d.WT = WinT + (size_t)l_ * NIN * DM; d.kind = 1; d.n0 = nb_ * 32; } \
            else if (nb_ < NIN / 32 + 32) { d.W = w_in + (size_t)l_ * DM * NPROJ; d.ldw = NPROJ; d.gf = norm_g + l_ * DM; d.WT = WvT + (size_t)l_ * DM * DM; d.coff = 2048; d.n0 = (nb_ - NIN / 32) * 32; } \
            else if (nb_ < NIN / 32 + 64) { d.W = w_attn_out + (size_t)l_ * DM * DM; d.WT = WaT + (size_t)l_ * DM * DM; d.n0 = (nb_ - NIN / 32 - 32) * 32; } \
            else if (nb_ < NIN / 32 + 96) { d.W = w_conv_out + (size_t)l_ * DM * DM; d.WT = WbT + (size_t)l_ * DM * DM; d.n0 = (nb_ - NIN / 32 - 64) * 32; } \
            else { d.W = w_o + (size_t)l_ * DM * DM; d.WT = WoT + (size_t)l_ * DM * DM; d.n0 = (nb_ - NIN / 32 - 96) * 32; } } while (0)
        for (int it = gw; it < DEPTH * IPL; it += 2 * NGW) {
            TrDesc d0, d1; f32x4 va[8], vb[8]; const bool two = it + NGW < DEPTH * IPL;
            TR_DECODE(d0, it); tr_load(d0, va, lane);
            if (two) { TR_DECODE(d1, it + NGW); tr_load(d1, vb, lane); }
            tr_finish(d0, va, scr, lane);
            if (two) tr_finish(d1, vb, scr, lane);
        }
#undef TR_DECODE
#pragma unroll 2
        for (int m = gw; m < MTOT; m += NGW) {
            const float* xrow = (m < 8 * SEQL) ? x_prompt + (size_t)m * DM : x_sample + (size_t)(m - 8 * SEQL) * DM;
            f32x4 v[4]; float s = 0.f;
#pragma unroll
            for (int j = 0; j < 4; ++j) { v[j] = ld4(xrow + 4 * lane + 256 * j); const f32x4 q = v[j] * v[j]; s += (q[0] + q[1]) + (q[2] + q[3]); }
            s = wave_sum(s);
            u32x2* o8 = (u32x2*)(XB_all + (size_t)m * DM) + lane;
#pragma unroll
            for (int j = 0; j < 4; ++j) { u32x2 w; w.x = pk2(v[j][0], v[j][1]); w.y = pk2(v[j][2], v[j][3]); o8[64 * j] = w; }
            if (lane < 16) part_all[(size_t)m * 16 + lane] = (lane == 0) ? s : 0.f;
        }
        if (bid == 0) {
            if (tid < DEPTH) { float s1 = 0.f, s2 = 0.f; for (int i = 0; i < 64; ++i) { s1 += lq1[tid * 64 + i] * lk1[tid * 64 + i]; s2 += lq2[tid * 64 + i] * lk2[tid * 64 + i]; }
                misc[tid] = expf(s1) - expf(s2) + (0.8f - 0.6f * expf(-0.3f * (float)tid)); }
            for (int i = tid; i < 8 * TABN; i += 512) { const int h = i / TABN, j = i % TABN; const int rel = j - TABZ; misc[64 + i] = rel_bias[rel_bucket(rel) * 8 + h] * LOG2E; }
        }
    }
    grid.sync();

    for (int c = 0; c < NCHUNK; ++c) {
        for (int l = 0; l < DEPTH; ++l) {
            {
                unsigned char* wsp = WSL(); bf16_t* XB = PTR(bf16_t, wsp, WS_XB) + (size_t)c * MC * DM; const float* part = PTR(float, wsp, WS_PART) + (size_t)c * MC * 16;
                pg8::Gemm g{XB, PTR(bf16_t, wsp, WS_WIN) + (size_t)l * NIN * DM, MC, NIN, DM, PTR(bf16_t, wsp, WS_WV) + (size_t)l * DM * DM, XB};
                pg8::DualOrder S; S.s0.init(MC, NIN, G, bid); S.s1.init(DM, MC, G, bid); S.G = G; S.c = bid;
                typedef EpiDual<EpiInProj, EpiVT> EP;
                EP E{EpiInProj{part, wsp, a.in[5] + l * 64, a.in[6] + l * 64, a.in[13] + (size_t)l * 3 * DM}, EpiVT{part, wsp}};
                pg8::gemm_phase<EP, pg8::DualOrder, true, true>(lds, g, S, E);
            }
            xcd_barrier(bar);
            {
                unsigned char* wsp = WSL(); const float* misc = PTR(float, wsp, WS_MISC);
                bf16_t *Qb = PTR(bf16_t, wsp, WS_Q), *Kb = PTR(bf16_t, wsp, WS_K), *VTb = PTR(bf16_t, wsp, WS_VT), *GAb = PTR(bf16_t, wsp, WS_GA), *Ub = PTR(bf16_t, wsp, WS_U), *Wb = PTR(bf16_t, wsp, WS_W), *BCb = PTR(bf16_t, wsp, WS_BC);
                const float* cw = a.in[13] + (size_t)l * 3 * DM; const float* subln_g = a.in[11];
                int tid_c = threadIdx.x; asm volatile("" : "+v"(tid_c));
                for (int it = bid * 512 + tid_c; it < (MC / 64) * 2 * 128; it += G * 512) {
                    const int c8 = (it & 127) * 8, j = it >> 7, row = (j >> 1) * 64 + ((j & 1) ? 63 : 0);
                    const size_t off = (size_t)row * DM + c8;
                    const u32x4 z4 = (u32x4){0u, 0u, 0u, 0u};
                    const u32x4 pv = ((row & (SEQL - 1)) != 0) ? *(const u32x4*)(Ub + off - DM) : z4, cv = *(const u32x4*)(Ub + off), nv = ((row & (SEQL - 1)) != SEQL - 1) ? *(const u32x4*)(Ub + off + DM) : z4, wv = *(const u32x4*)(Wb + off);
                    float res[8];
#pragma unroll
                    for (int e = 0; e < 4; ++e) {
                        res[2 * e] = bflo(wv[e]) * (cw[c8 + 2 * e] * bflo(pv[e]) + cw[DM + c8 + 2 * e] * bflo(cv[e]) + cw[2 * DM + c8 + 2 * e] * bflo(nv[e]));
                        res[2 * e + 1] = bfhi(wv[e]) * (cw[c8 + 2 * e + 1] * bfhi(pv[e]) + cw[DM + c8 + 2 * e + 1] * bfhi(cv[e]) + cw[2 * DM + c8 + 2 * e + 1] * bfhi(nv[e])); }
                    u32x4 o; o.x = pkbf(res[0], res[1]); o.y = pkbf(res[2], res[3]); o.z = pkbf(res[4], res[5]); o.w = pkbf(res[6], res[7]);
                    *(u32x4*)(BCb + off) = o;
                }
                const float lam = misc[l], osc = 1.0f - (0.8f - 0.6f * expf(-0.3f * (float)l));
                const int xcd = bid & 7, slot = bid >> 3, nslot = (G + 7) >> 3;
                for (int i = 0; i < (CH_SEQ * 8) / 8; ++i) {
                    const int p = 8 * i + xcd, seq = p >> 3, h = p & 7;
                    for (int qb = slot; qb < SEQL / 128; qb += nslot)
                        att::attn_unit(lds, Qb, Kb, VTb, GAb, Qb, misc + 64 + h * TABN, lam, subln_g + l * 128, osc, seq, h, qb, (2 * slot) & 63);
                }
            }
            xcd_barrier(bar);
            {
                unsigned char* wsp = WSL();
                pg8::Gemm g{PTR(bf16_t, wsp, WS_Q), PTR(bf16_t, wsp, WS_WA) + (size_t)l * DM * DM, MC, DM, DM, PTR(bf16_t, wsp, WS_BC), PTR(bf16_t, wsp, WS_WB) + (size_t)l * DM * DM};
                pg8::DualOrder S; S.s0.init(MC, DM, G, bid); S.s1.init(MC, DM, G, bid); S.G = G; S.c = bid;
                typedef EpiDual<EpiGate<0>, EpiGate<1>> EP;
                EP E{EpiGate<0>{wsp}, EpiGate<1>{wsp}};
                pg8::gemm_phase<EP, pg8::DualOrder, true, true>(lds, g, S, E);
            }
            xcd_barrier(bar);
            {
                unsigned char* wsp = WSL(); float* xo = a.out + (size_t)c * MC * DM; const float* xin0 = (c < 2) ? a.in[0] + (size_t)c * MC * DM : a.in[1];
                pg8::Gemm g{PTR(bf16_t, wsp, WS_W), PTR(bf16_t, wsp, WS_WO) + (size_t)l * DM * DM, MC, DM, DM, nullptr, nullptr}; pg8::StaticOrder S; S.init(MC, DM, G, bid);
                EpiOut E{xin0, xo, PTR(bf16_t, wsp, WS_XB) + (size_t)c * MC * DM, PTR(float, wsp, WS_PART) + (size_t)c * MC * 16, l == 0, l == DEPTH - 1};
                pg8::gemm_phase<EpiOut, pg8::StaticOrder, true, true>(lds, g, S, E);
            }
            xcd_barrier(bar);
        }
    }
}

extern "C" void kernel_launch(void* const* d_in, const int* in_sizes, int n_in, void* d_out, int out_size, void* d_ws, size_t ws_size, hipStream_t stream) {
    static int grid = 0;
    if (grid == 0) {
        if (n_in != 16 || ws_size < WS_END) { fprintf(stderr, "kernel_launch: unexpected n_in %d or ws_size %zu (< %zu)\n", n_in, ws_size, (size_t)WS_END); grid = -1; return; }
        int dev = 0, cus = 0, per_cu = 0;
        hipGetDevice(&dev); hipDeviceGetAttribute(&cus, hipDeviceAttributeMultiprocessorCount, dev);
        if (hipFuncSetAttribute((const void*)fwd_kernel, hipFuncAttributeMaxDynamicSharedMemorySize, LDS_BYTES) != hipSuccess) { fprintf(stderr, "hipFuncSetAttribute failed\n"); grid = -1; return; }
        if (hipOccupancyMaxActiveBlocksPerMultiprocessor(&per_cu, (const void*)fwd_kernel, 512, LDS_BYTES) != hipSuccess || per_cu < 1) { fprintf(stderr, "occupancy query: %d\n", per_cu); per_cu = 1; }
        (void)hipGetLastError();
        grid = cus * 1;
    }
    if (grid < 0) return;
    if (hipMemsetAsync((char*)d_ws + WS_BAR, 0, 16384, stream) != hipSuccess) { fprintf(stderr, "memset failed\n"); return; }
    Args a{};
    for (int i = 0; i < 16; ++i) a.in[i] = (const float*)d_in[i];
    a.out = (float*)d_out; a.ws = (unsigned char*)d_ws;
    void* args[] = {&a};
    hipError_t e = hipLaunchCooperativeKernel((const void*)fwd_kernel, dim3(grid), dim3(512), args, LDS_BYTES, stream);
    if (e != hipSuccess) fprintf(stderr, "cooperative launch failed: %s (grid %d)\n", hipGetErrorString(e), grid);
}
```
